# Optimizing an MI355X kernel written in HIP

```python
import jax, jax.numpy as jnp
from jax import lax
import numpy as np

D_MODEL = 2048
BATCH = 2
SEQ = 8192
DEPTH = 1

CHUNK = 64
SB_HEADS = 8
SB_HEAD_DIM = 128
SB_WIDTH = SB_HEADS * SB_HEAD_DIM
Q_BLOCK = 128
SGU_GROUPS = 8
SGU_GROUP_DIM = 128
SGU_WIDTH = SGU_GROUPS * SGU_GROUP_DIM
SGU_BLOCK = 128
N_BRANCHES = 2
IN_COLS = 3 * SB_WIDTH + 2 * SGU_WIDTH + N_BRANCHES * D_MODEL
N_GROUPS = 4
EXPERTS_PER_GROUP = 8
N_EXPERTS = N_GROUPS * EXPERTS_PER_GROUP
TOP_K_INNER = 2
D_EXPERT = 512
EXPERT_BLOCK = 128
LN_EPS = 1e-5
DEEPNORM_ALPHA = (2.0 * DEPTH) ** 0.25
DEEPNORM_BETA = (8.0 * DEPTH) ** -0.25

kernel_name = "chunk_causal_hybrid_sb_sgu_hmoe_deepnorm"


def layer_norm(x, gain=None, bias=None):
    xf = x.astype(jnp.float32)
    mu = jnp.mean(xf, axis=-1, keepdims=True)
    var = jnp.mean(jnp.square(xf - mu), axis=-1, keepdims=True)
    y = (xf - mu) * lax.rsqrt(var + LN_EPS)
    if gain is not None:
        y = y * gain.astype(jnp.float32) + bias.astype(jnp.float32)
    return y.astype(x.dtype)


def modulate(x, shift, scale):
    return layer_norm(x) * (1 + scale[:, None, :]) + shift[:, None, :]


def stick_breaking_attention(q, k, v):
    b, h, s, dh = q.shape
    n_qb = s // Q_BLOCK
    kf = k.astype(jnp.float32)
    vf = v.astype(jnp.float32)
    qb = q.astype(jnp.float32).reshape(b, h, n_qb, Q_BLOCK, dh).transpose(2, 0, 1, 3, 4)
    key_pos = jnp.arange(s)
    scale = dh ** -0.5

    def one_block(args):
        q_i, blk = args
        z = jnp.einsum('bhqd,bhkd->bhqk', q_i, kf) * scale
        q_pos = blk * Q_BLOCK + jnp.arange(Q_BLOCK)
        causal = key_pos[None, :] < q_pos[:, None]
        log_keep = jnp.where(causal, jax.nn.log_sigmoid(-z), 0.0)
        between = lax.cumsum(log_keep, axis=3, reverse=True) - log_keep
        w = jnp.where(causal, jnp.exp(jax.nn.log_sigmoid(z) + between), 0.0)
        return jnp.einsum('bhqk,bhkd->bhqd', w, vf)

    out = lax.map(one_block, (qb, jnp.arange(n_qb)))
    return out.transpose(1, 0, 3, 2, 4).reshape(b, s, h * dh).astype(q.dtype)


def spatial_gating(u, v, w_s, b_s, ln_g, ln_b):
    b, s, _ = v.shape
    n_blk = s // SGU_BLOCK
    v = layer_norm(v, ln_g, ln_b)
    pos = jnp.arange(SGU_BLOCK)
    mask = (pos[None, :] // CHUNK) <= (pos[:, None] // CHUNK)
    w = jnp.where(mask[None], w_s, 0.0).astype(v.dtype)
    vb = v.reshape(b, n_blk, SGU_BLOCK, SGU_GROUPS, SGU_GROUP_DIM)
    mixed = jnp.einsum('gts,bnsgd->bntgd', w, vb) + b_s.T[None, None, :, :, None]
    return u * mixed.reshape(b, s, SGU_WIDTH)


def hierarchical_moe(h, w_group, b_group, w_router, b_router, w_gate, w_up, w_down):
    b, s, d = h.shape
    n = b * s
    xf = h.reshape(n, d)
    group_logits = (xf @ w_group).astype(jnp.float32) + b_group.astype(jnp.float32)
    group_prob = jax.nn.softmax(group_logits, axis=-1)
    _, g_sel = lax.top_k(group_logits, 1)
    p_group = jnp.take_along_axis(group_prob, g_sel, axis=1)
    expert_logits = ((xf @ w_router).astype(jnp.float32) + b_router.astype(jnp.float32)
                     ).reshape(n, N_GROUPS, EXPERTS_PER_GROUP)
    in_group = jnp.take_along_axis(expert_logits, g_sel[:, :, None], axis=1)[:, 0]
    top_val, top_idx = lax.top_k(in_group, TOP_K_INNER)
    weights = p_group * jax.nn.softmax(top_val, axis=-1)
    expert_id = g_sel * EXPERTS_PER_GROUP + top_idx

    a = n * TOP_K_INNER
    exp_flat = expert_id.reshape(a)
    tok_flat = jnp.arange(a) // TOP_K_INNER
    w_flat = weights.reshape(a)
    order = jnp.argsort(exp_flat)
    exp_sorted = exp_flat[order]
    tok_sorted = tok_flat[order]
    w_sorted = w_flat[order]
    counts = jax.ops.segment_sum(jnp.ones((a,), jnp.int32), exp_flat, num_segments=N_EXPERTS)
    padded = (counts + EXPERT_BLOCK - 1) // EXPERT_BLOCK * EXPERT_BLOCK
    starts = jnp.cumsum(counts) - counts
    pad_ends = jnp.cumsum(padded)
    pad_starts = pad_ends - padded
    dest = pad_starts[exp_sorted] + jnp.arange(a) - starts[exp_sorted]
    n_rows = a + N_EXPERTS * EXPERT_BLOCK
    n_blocks = n_rows // EXPERT_BLOCK
    row_tok = jnp.zeros((n_rows,), jnp.int32).at[dest].set(tok_sorted)
    row_w = jnp.zeros((n_rows,), w_sorted.dtype).at[dest].set(w_sorted)
    block_expert = jnp.minimum(
        jnp.searchsorted(pad_ends, jnp.arange(n_blocks) * EXPERT_BLOCK, side='right'),
        N_EXPERTS - 1)
    xs = xf[row_tok].reshape(n_blocks, EXPERT_BLOCK, d)

    def expert_block(args):
        xb, e = args
        hb = jax.nn.silu(xb @ w_gate[e]) * (xb @ w_up[e])
        return hb @ w_down[e]

    ys = lax.map(expert_block, (xs, block_expert)).reshape(n_rows, d)
    out = jax.ops.segment_sum(ys * row_w[:, None].astype(ys.dtype), row_tok, num_segments=n)
    return out.reshape(b, s, d)


def setup_inputs(seed: int = 0) -> dict:
    key = jax.random.key(seed)
    ks = jax.random.split(key, 24)
    f32 = jnp.float32
    d = D_MODEL

    def nrm(k, shape, scale):
        return jax.random.normal(k, shape, f32) * scale

    return {
        "x": nrm(ks[0], (BATCH, SEQ, d), 1.0),
        "c": nrm(ks[1], (BATCH, d), 1.0),
        "w_ada": nrm(ks[2], (DEPTH, d, 6 * d), d ** -0.5),
        "b_ada": nrm(ks[3], (DEPTH, 6 * d), 0.01),
        "w_in": nrm(ks[4], (DEPTH, d, IN_COLS), d ** -0.5),
        "sgu_w": nrm(ks[5], (DEPTH, SGU_GROUPS, SGU_BLOCK, SGU_BLOCK), 0.5 * SGU_BLOCK ** -0.5),
        "sgu_b": 1.0 + nrm(ks[6], (DEPTH, SGU_GROUPS, SGU_BLOCK), 0.02),
        "sgu_ln_g": 1.0 + nrm(ks[7], (DEPTH, SGU_WIDTH), 0.02),
        "sgu_ln_b": nrm(ks[8], (DEPTH, SGU_WIDTH), 0.02),
        "w_proj_a": nrm(ks[9], (DEPTH, SB_WIDTH, d), SB_WIDTH ** -0.5),
        "w_proj_b": nrm(ks[10], (DEPTH, SGU_WIDTH, d), SGU_WIDTH ** -0.5),
        "w_out": nrm(ks[11], (DEPTH, d, d), DEEPNORM_BETA * d ** -0.5),
        "ln1_g": 1.0 + nrm(ks[12], (DEPTH, d), 0.02),
        "ln1_b": nrm(ks[13], (DEPTH, d), 0.02),
        "w_group": nrm(ks[14], (DEPTH, d, N_GROUPS), d ** -0.5),
        "b_group": nrm(ks[15], (DEPTH, N_GROUPS), 0.01),
        "w_router": nrm(ks[16], (DEPTH, d, N_EXPERTS), d ** -0.5),
        "b_router": nrm(ks[17], (DEPTH, N_EXPERTS), 0.01),
        "w_gate": nrm(ks[18], (DEPTH, N_EXPERTS, d, D_EXPERT), d ** -0.5),
        "w_up": nrm(ks[19], (DEPTH, N_EXPERTS, d, D_EXPERT), d ** -0.5),
        "w_down": nrm(ks[20], (DEPTH, N_EXPERTS, D_EXPERT, d), DEEPNORM_BETA * D_EXPERT ** -0.5),
        "ln2_g": 1.0 + nrm(ks[21], (DEPTH, d), 0.02),
        "ln2_b": nrm(ks[22], (DEPTH, d), 0.02),
    }


def reference(x, c, w_ada, b_ada, w_in, sgu_w, sgu_b, sgu_ln_g, sgu_ln_b, w_proj_a, w_proj_b,
              w_out, ln1_g, ln1_b, w_group, b_group, w_router, b_router, w_gate, w_up, w_down,
              ln2_g, ln2_b):
    b, s, d = x.shape
    split_at = [SB_WIDTH, 2 * SB_WIDTH, 3 * SB_WIDTH, 3 * SB_WIDTH + SGU_WIDTH,
                3 * SB_WIDTH + 2 * SGU_WIDTH, 3 * SB_WIDTH + 2 * SGU_WIDTH + d]
    c_act = jax.nn.silu(c)
    for l in range(DEPTH):
        mod = c_act @ w_ada[l] + b_ada[l]
        shift1, scale1, gate1, shift2, scale2, gate2 = jnp.split(mod, 6, axis=-1)

        h = modulate(x, shift1, scale1)
        proj = h @ w_in[l]
        q, k, v, su, sv, ga, gb = jnp.split(proj, split_at, axis=-1)
        to_heads = lambda t: t.reshape(b, s, SB_HEADS, SB_HEAD_DIM).transpose(0, 2, 1, 3)
        out_a = stick_breaking_attention(to_heads(q), to_heads(k), to_heads(v))
        out_b = spatial_gating(jax.nn.gelu(su, approximate=False), jax.nn.gelu(sv, approximate=False),
                               sgu_w[l], sgu_b[l], sgu_ln_g[l], sgu_ln_b[l])
        merged = jax.nn.sigmoid(ga) * (out_a @ w_proj_a[l]) + jax.nn.sigmoid(gb) * (out_b @ w_proj_b[l])
        y = merged @ w_out[l]
        x = layer_norm(DEEPNORM_ALPHA * x + gate1[:, None, :] * y, ln1_g[l], ln1_b[l])

        h = modulate(x, shift2, scale2)
        y = hierarchical_moe(h, w_group[l], b_group[l], w_router[l], b_router[l],
                             w_gate[l], w_up[l], w_down[l])
        x = layer_norm(DEEPNORM_ALPHA * x + gate2[:, None, :] * y, ln2_g[l], ln2_b[l])
    return x
```

```cpp
#include <hip/hip_runtime.h>
#include <cstdio>
#include <cstdint>

#ifndef MK_PER_PHASE
#define MK_PER_PHASE 1
#endif

#define GAS __attribute__((address_space(1)))
#define LAS __attribute__((address_space(3)))
typedef unsigned short bf16_t;
typedef short bf16x8 __attribute__((ext_vector_type(8)));
typedef short s16x4 __attribute__((ext_vector_type(4)));
typedef float f32x2 __attribute__((ext_vector_type(2)));
typedef float f32x4 __attribute__((ext_vector_type(4)));
typedef float f32x16 __attribute__((ext_vector_type(16)));
typedef unsigned u32x2 __attribute__((ext_vector_type(2)));
typedef unsigned u32x4 __attribute__((ext_vector_type(4)));
typedef __bf16 bf16x2_t __attribute__((ext_vector_type(2)));

constexpr int BATCH = 2, SEQ = 8192, DM = 2048, M = BATCH * SEQ;
constexpr int NHEAD = 8, HD = 128, SBW = 1024, SGW = 1024;
constexpr int INC = 9216, N1 = 7168;
constexpr int NE = 32, DE = 512, ECAP = 16384;
constexpr int MODW = 6 * DM;
constexpr float LN_EPS = 1e-5f;
constexpr float ALPHA = 1.189207115002721f;
constexpr float QSCALE = 0.08838834764831845f * 1.4426950408889634f;
constexpr int HBROWS = 40960;

constexpr size_t MiB = 1u << 20;
constexpr size_t WS_CTL = 0, CTL_ZERO_BYTES = 1 * MiB;
constexpr size_t WS_MODP = 1 * MiB;
constexpr size_t WS_MOD = 2 * MiB;
constexpr size_t WS_TOK = 3 * MiB;
constexpr size_t WS_ASG = 5 * MiB;
constexpr size_t WS_WAB = 6 * MiB;
constexpr size_t WS_WOUT = 14 * MiB;
constexpr size_t WS_WGU = 22 * MiB;
constexpr size_t WS_WD = 150 * MiB;
constexpr size_t WS_WIN = 214 * MiB;
constexpr size_t WS_H = 250 * MiB;
constexpr size_t WS_Q = 314 * MiB, WS_K = 346 * MiB, WS_SU = 378 * MiB, WS_VT = 410 * MiB;
constexpr size_t WS_MRG = 314 * MiB;
constexpr size_t WS_YS = 314 * MiB;
constexpr size_t WS_SA = 474 * MiB, WS_SB = 538 * MiB;
constexpr size_t WS_V1 = 474 * MiB;
constexpr size_t WS_OAB = 602 * MiB;
constexpr size_t WS_HB = 602 * MiB;
constexpr size_t WS_END = 666 * MiB;
constexpr int CW_CNT = 64;
constexpr int CW_BAR = 4096;

constexpr int RING_BYTES = 131072;
constexpr int LDSCTL_OFF = RING_BYTES, MISC_OFF = LDSCTL_OFF + 320;
constexpr int LDS_BYTES = 147456;
constexpr int NWAVES = 8;

#define RLX_AGENT __ATOMIC_RELAXED, __HIP_MEMORY_SCOPE_AGENT
#define LDS_WAIT() asm volatile("s_waitcnt lgkmcnt(0)" ::: "memory")
__device__ __forceinline__ unsigned f2bf(float f) { unsigned u = __builtin_bit_cast(unsigned, f); return (u + 0x7fffu + ((u >> 16) & 1u)) >> 16; }
__device__ __forceinline__ unsigned pk2(float lo, float hi) { f32x2 v = {lo, hi}; bf16x2_t b = __builtin_convertvector(v, bf16x2_t); return __builtin_bit_cast(unsigned, b); }
__device__ __forceinline__ float bflo(unsigned u) { return __uint_as_float(u << 16); }
__device__ __forceinline__ float bfhi(unsigned u) { return __uint_as_float(u & 0xffff0000u); }
__device__ __forceinline__ float wave_sum(float v) {
#pragma unroll
    for (int o = 1; o < 64; o <<= 1) v += __shfl_xor(v, o);
    return v;
}
__device__ __forceinline__ float sigmoidf_(float x) { return __builtin_amdgcn_rcpf(1.0f + __builtin_amdgcn_exp2f(-1.4426950408889634f * x)); }
__device__ __forceinline__ f32x2 gelu_pk(f32x2 v) {
    const f32x2 av = __builtin_elementwise_abs(v), d = av * 0.2316418882f + 1.0f;
    f32x2 t; t.x = __builtin_amdgcn_rcpf(d.x); t.y = __builtin_amdgcn_rcpf(d.y);
    f32x2 q = t * 0.5307027145f + (-0.7265760135f); q = q * t + 0.7107068705f; q = q * t + (-0.142248368f); q = q * t + 0.127414796f; q = q * t;
    const f32x2 s = (v * v) * (-0.72134752044f);
    f32x2 e; e.x = __builtin_amdgcn_exp2f(s.x); e.y = __builtin_amdgcn_exp2f(s.y);
    const f32x2 m = v * (q * e), r = v - m;
    f32x2 o; o.x = v.x < 0.f ? m.x : r.x; o.y = v.y < 0.f ? m.y : r.y; return o;
}
__device__ __forceinline__ int xcd_remap(int L, int nwg) { const int q = nwg / 8, r = nwg % 8, xcd = L % 8, off = L / 8; return (xcd < r ? xcd * (q + 1) : r * (q + 1) + (xcd - r) * q) + off; }

namespace pg8 {
constexpr int BM = 256, BK = 64, HALF = 128, HTB = HALF * BK * 2, STAGE_BYTES = 8 * HTB, NXCD = 8, WGM = 8;
__host__ __device__ __forceinline__ int lds_byte(int r, int c) { const int st = (r >> 4) * 2 + (c >> 5), rr = r & 15, cc = c & 31, ob = rr * 64 + cc * 2; return st * 1024 + (ob ^ (((ob >> 9) & 1) << 5)); }
__host__ __device__ __forceinline__ void stage_rc(int b, int& R, int& C) { const int st = b / 1024, sb = b % 1024, swz = sb ^ (((sb >> 9) & 1) << 5); R = (st >> 1) * 16 + swz / 64; C = (st & 1) * 32 + (swz % 64) / 2; }
__host__ __device__ __forceinline__ int perm32(int rho) { const int n = rho >> 4, i = rho & 15; return 8 * (i >> 2) + 4 * n + (i & 3); }

struct Unit { int pm, pn, ax, ax2; };
struct Gemm { const bf16_t* A; const bf16_t* Bt; int K; };

struct StaticOrder {
    static constexpr bool GATHER = false;
    int nM, nN, nwg, G, c;
    __device__ void init(int Mr, int Nr, int G_, int c_) { nM = Mr / BM; nN = Nr / BM; nwg = nM * nN; G = G_; c = c_; }
    __device__ bool next(int i, Unit& u) const {
        const long L = (long)i * G + c; if (L >= nwg) return false;
        const int wgid = xcd_remap((int)L, nwg);
        const int nig = WGM * nN, gid = wgid / nig, fm = gid * WGM, gsz = (nM - fm) < WGM ? (nM - fm) : WGM;
        u.pm = fm + ((wgid % nig) % gsz); u.pn = (wgid % nig) / gsz; u.ax = 0; u.ax2 = 0; return true;
    }
    __device__ __forceinline__ int row_src(const Unit&, int) const { return 0; }
};
struct PairOrder {
    static constexpr bool GATHER = false;
    StaticOrder so;
    __device__ bool next(int i, Unit& u) const { Unit t; if (!so.next(i >> 1, t)) return false; const int hf = i & 1; u.pm = t.pm + 64 * hf; u.pn = t.pn + 8 * hf; u.ax = hf; u.ax2 = 0; return true; }
    __device__ __forceinline__ int row_src(const Unit&, int) const { return 0; }
};
template <bool G_, int SH> struct MoeOrder {
    static constexpr bool GATHER = G_;
    const LAS int* tp;
    const int* tok;
    int G, c, total;
    __device__ bool next(int i, Unit& u) const {
        const long L = (long)i * G + c; if (L >= total) return false;
        const int wgid = xcd_remap((int)L, total);
        const int tile = wgid >> SH, pn = wgid & ((1 << SH) - 1);
        int e = 0;
#pragma unroll 8
        for (int j = 1; j < NE; ++j) e += (tp[j] <= tile) ? 1 : 0;
        const int mt = tile - tp[e]; int valid = tp[40 + e] - mt * 256; valid = valid > 256 ? 256 : valid;
        u.pm = tile; u.pn = (e << SH) + pn; u.ax = e * ECAP + mt * 256; u.ax2 = valid; return true;
    }
    __device__ __forceinline__ int row_src(const Unit& u, int r) const { return r < u.ax2 ? tok[u.ax + r] : 0; }
};

__device__ __forceinline__ unsigned cvt_pk_bf16(float lo, float hi) { return pk2(lo, hi); }

#define PG8_ACC f32x4 (&acc)[2][2][4][2]

struct EpiG1 {
    static constexpr bool PERM = true, KEEP = false;
    bf16_t *q, *k, *su, *sa, *sb;
    __device__ __forceinline__ bool keep(const Unit&) const { return false; }
    __device__ __forceinline__ void operator()(PG8_ACC, const Unit& u, int wr, int wc, int fr, int fq) const {
        bf16_t* base; int ldc, ct, mode;
        if (u.pn < 4) { base = q; ldc = 1024; ct = u.pn; mode = 0; }
        else if (u.pn < 8) { base = k; ldc = 1024; ct = u.pn - 4; mode = 1; }
        else if (u.pn < 12) { base = su; ldc = 1024; ct = u.pn - 8; mode = 2; }
        else if (u.pn < 20) { base = sa; ldc = 2048; ct = u.pn - 12; mode = 3; }
        else { base = sb; ldc = 2048; ct = u.pn - 20; mode = 3; }
        const int row0 = u.pm * BM + wr * 64 + fr, col0 = ct * BM + wc * 32 + 8 * fq;
#pragma unroll
        for (int ai = 0; ai < 2; ++ai)
#pragma unroll
            for (int m = 0; m < 4; ++m) { bf16_t* rowp = base + (size_t)(row0 + ai * HALF + m * 16) * ldc + col0;
#pragma unroll
                for (int bj = 0; bj < 2; ++bj) { f32x4 v0 = acc[ai][bj][m][0], v1 = acc[ai][bj][m][1];
                    if (mode == 0) { v0 = v0 * QSCALE; v1 = v1 * QSCALE; }
                    else if (mode == 2) { f32x2 a = gelu_pk((f32x2){v0[0], v0[1]}), b = gelu_pk((f32x2){v0[2], v0[3]}), c = gelu_pk((f32x2){v1[0], v1[1]}), d = gelu_pk((f32x2){v1[2], v1[3]});
                        v0 = (f32x4){a.x, a.y, b.x, b.y}; v1 = (f32x4){c.x, c.y, d.x, d.y}; }
                    else if (mode == 3) {
#pragma unroll
                        for (int j = 0; j < 4; ++j) { v0[j] = sigmoidf_(v0[j]); v1[j] = sigmoidf_(v1[j]); } }
                    u32x4 w; w.x = cvt_pk_bf16(v0[0], v0[1]); w.y = cvt_pk_bf16(v0[2], v0[3]); w.z = cvt_pk_bf16(v1[0], v1[1]); w.w = cvt_pk_bf16(v1[2], v1[3]);
                    *(u32x4*)(rowp + bj * HALF) = w; } }
    }
};
struct EpiG2 {
    static constexpr bool PERM = true, KEEP = false;
    bf16_t* vt;
    __device__ __forceinline__ bool keep(const Unit&) const { return false; }
    __device__ __forceinline__ void operator()(PG8_ACC, const Unit& u, int wr, int wc, int fr, int fq) const {
        const int row0 = u.pm * BM + wr * 64 + fr, col0 = u.pn * BM + wc * 32 + 8 * fq; const bool gl = u.pm >= 4;
#pragma unroll
        for (int ai = 0; ai < 2; ++ai)
#pragma unroll
            for (int m = 0; m < 4; ++m) { bf16_t* rowp = vt + (size_t)(row0 + ai * HALF + m * 16) * M + col0;
#pragma unroll
                for (int bj = 0; bj < 2; ++bj) { f32x4 v0 = acc[ai][bj][m][0], v1 = acc[ai][bj][m][1];
                    if (gl) { f32x2 a = gelu_pk((f32x2){v0[0], v0[1]}), b = gelu_pk((f32x2){v0[2], v0[3]}), c = gelu_pk((f32x2){v1[0], v1[1]}), d = gelu_pk((f32x2){v1[2], v1[3]});
                        v0 = (f32x4){a.x, a.y, b.x, b.y}; v1 = (f32x4){c.x, c.y, d.x, d.y}; }
                    u32x4 w; w.x = cvt_pk_bf16(v0[0], v0[1]); w.y = cvt_pk_bf16(v0[2], v0[3]); w.z = cvt_pk_bf16(v1[0], v1[1]); w.w = cvt_pk_bf16(v1[2], v1[3]);
                    *(u32x4*)(rowp + bj * HALF) = w; } }
    }
};
struct EpiGate {
    static constexpr bool PERM = true, KEEP = true;
    const bf16_t *sa, *sb; bf16_t* O;
    __device__ __forceinline__ bool keep(const Unit& u) const { return u.ax == 0; }
    __device__ __forceinline__ void operator()(PG8_ACC, const Unit& u, int wr, int wc, int fr, int fq) const {
        const int pm = u.ax ? u.pm - 64 : u.pm, pn = u.ax ? u.pn - 8 : u.pn;
        const int row0 = pm * BM + wr * 64 + fr, col0 = pn * BM + wc * 32 + 8 * fq;
#pragma unroll
        for (int ai = 0; ai < 2; ++ai)
#pragma unroll
            for (int m = 0; m < 4; ++m) { const size_t off = (size_t)(row0 + ai * HALF + m * 16) * DM + col0;
#pragma unroll
                for (int bj = 0; bj < 2; ++bj) {
                    const u32x4 b4 = *(const u32x4*)(sb + off + bj * HALF);
                    float s[8] = {bflo(b4.x), bfhi(b4.x), bflo(b4.y), bfhi(b4.y), bflo(b4.z), bfhi(b4.z), bflo(b4.w), bfhi(b4.w)};
#pragma unroll
                    for (int j = 0; j < 8; ++j) s[j] = fmaxf(s[j], 1e-30f);
                    if (u.ax == 0) {
                        const u32x4 a4 = *(const u32x4*)(sa + off + bj * HALF);
                        const float a[8] = {bflo(a4.x), bfhi(a4.x), bflo(a4.y), bfhi(a4.y), bflo(a4.z), bfhi(a4.z), bflo(a4.w), bfhi(a4.w)};
#pragma unroll
                        for (int j = 0; j < 4; ++j) { acc[ai][bj][m][0][j] *= a[j] * __builtin_amdgcn_rcpf(s[j]); acc[ai][bj][m][1][j] *= a[4 + j] * __builtin_amdgcn_rcpf(s[4 + j]); }
                    } else {
                        f32x4 v0 = acc[ai][bj][m][0], v1 = acc[ai][bj][m][1];
#pragma unroll
                        for (int j = 0; j < 4; ++j) { v0[j] *= s[j]; v1[j] *= s[4 + j]; }
                        u32x4 w; w.x = cvt_pk_bf16(v0[0], v0[1]); w.y = cvt_pk_bf16(v0[2], v0[3]); w.z = cvt_pk_bf16(v1[0], v1[1]); w.w = cvt_pk_bf16(v1[2], v1[3]);
                        *(u32x4*)(O + off + bj * HALF) = w;
                    } } }
    }
};
struct EpiV1 {
    static constexpr bool PERM = false, KEEP = false;
    const float* x; const float* mod; float* O;
    __device__ __forceinline__ bool keep(const Unit&) const { return false; }
    __device__ __forceinline__ void operator()(PG8_ACC, const Unit& u, int wr, int wc, int fr, int fq) const {
        const int row0 = u.pm * BM + wr * 64 + fr, col0 = u.pn * BM + wc * 32 + 4 * fq;
        const float* g1 = mod + (size_t)(u.pm >> 5) * MODW + 2 * DM;
        f32x4 gv[2][2];
#pragma unroll
        for (int bj = 0; bj < 2; ++bj)
#pragma unroll
            for (int n = 0; n < 2; ++n) gv[bj][n] = *(const f32x4*)(g1 + col0 + bj * HALF + n * 16);
#pragma unroll
        for (int ai = 0; ai < 2; ++ai)
#pragma unroll
            for (int m = 0; m < 4; ++m) { const size_t off = (size_t)(row0 + ai * HALF + m * 16) * DM + col0;
#pragma unroll
                for (int bj = 0; bj < 2; ++bj)
#pragma unroll
                    for (int n = 0; n < 2; ++n) { const f32x4 xv = *(const f32x4*)(x + off + bj * HALF + n * 16);
                        *(f32x4*)(O + off + bj * HALF + n * 16) = xv * ALPHA + gv[bj][n] * acc[ai][bj][m][n]; } }
    }
};
struct EpiGU {
    static constexpr bool PERM = true, KEEP = false;
    bf16_t* hb;
    __device__ __forceinline__ bool keep(const Unit&) const { return false; }
    __device__ __forceinline__ void operator()(PG8_ACC, const Unit& u, int wr, int wc, int fr, int fq) const {
        const int row0 = u.pm * BM + wr * 64 + fr, col0 = (u.pn & 3) * HALF + wc * 32 + 8 * fq;
#pragma unroll
        for (int ai = 0; ai < 2; ++ai)
#pragma unroll
            for (int m = 0; m < 4; ++m) { bf16_t* rowp = hb + (size_t)(row0 + ai * HALF + m * 16) * DE + col0;
                f32x4 g0 = acc[ai][0][m][0], g1 = acc[ai][0][m][1]; const f32x4 u0 = acc[ai][1][m][0], u1 = acc[ai][1][m][1];
#pragma unroll
                for (int j = 0; j < 4; ++j) { g0[j] = g0[j] * sigmoidf_(g0[j]) * u0[j]; g1[j] = g1[j] * sigmoidf_(g1[j]) * u1[j]; }
                u32x4 w; w.x = cvt_pk_bf16(g0[0], g0[1]); w.y = cvt_pk_bf16(g0[2], g0[3]); w.z = cvt_pk_bf16(g1[0], g1[1]); w.w = cvt_pk_bf16(g1[2], g1[3]);
                *(u32x4*)rowp = w; }
    }
};
struct EpiDown {
    static constexpr bool PERM = true, KEEP = false;
    bf16_t* ys;
    __device__ __forceinline__ bool keep(const Unit&) const { return false; }
    __device__ __forceinline__ void operator()(PG8_ACC, const Unit& u, int wr, int wc, int fr, int fq) const {
        const int row0 = u.pm * BM + wr * 64 + fr, col0 = (u.pn & 7) * BM + wc * 32 + 8 * fq;
#pragma unroll
        for (int ai = 0; ai < 2; ++ai)
#pragma unroll
            for (int m = 0; m < 4; ++m) { bf16_t* rowp = ys + (size_t)(row0 + ai * HALF + m * 16) * DM + col0;
#pragma unroll
                for (int bj = 0; bj < 2; ++bj) { const f32x4 v0 = acc[ai][bj][m][0], v1 = acc[ai][bj][m][1];
                    u32x4 w; w.x = cvt_pk_bf16(v0[0], v0[1]); w.y = cvt_pk_bf16(v0[2], v0[3]); w.z = cvt_pk_bf16(v1[0], v1[1]); w.w = cvt_pk_bf16(v1[2], v1[3]);
                    *(u32x4*)(rowp + bj * HALF) = w; } }
    }
};

template <class Epi, class Sched, bool ALIGN_EPI>
__device__ __forceinline__ void gemm_phase(LAS unsigned char* lds, const Gemm g, const Sched& S, const Epi& E) {
    const int tid = threadIdx.x, wid = __builtin_amdgcn_readfirstlane(tid >> 6), lane = tid & 63, wr = wid >> 2, wc = wid & 3, fr = lane & 15, fq = lane >> 4;
    const int K = g.K, nt = K / BK;
    unsigned voffA[2], voffB[2]; int stR[2], stC[2];
#pragma unroll
    for (int i = 0; i < 2; ++i) { int R, C; stage_rc(tid * 16 + i * 8192, R, C); const int Rb = Epi::PERM ? ((R & ~31) + perm32(R & 31)) : R;
        stR[i] = R; stC[i] = C; voffA[i] = (unsigned)(R * K + C) * 2u; voffB[i] = (unsigned)(Rb * K + C) * 2u; }
    const size_t kstep = (size_t)(BK * 2);
    const size_t hstep = (size_t)HALF * K * 2;
    const size_t tstep = 2 * hstep;
    const unsigned ldsw = (unsigned)wid * 1024u;
    const int aoff = lds_byte(wr * 64 + fr, fq * 8), boff = lds_byte(wc * 32 + fr, fq * 8);
#define PG8_SA(b, h) (((b) * 2 + (h)) * HTB)
#define PG8_SB(b, h) ((4 + (b) * 2 + (h)) * HTB)
#define PG8_STAGE(bufoff, gbase, voff) do { _Pragma("unroll") for (int _i = 0; _i < 2; ++_i) \
        __builtin_amdgcn_global_load_lds((const unsigned*)((const char*)(gbase) + (voff)[_i]), (LAS unsigned*)(lds + (bufoff) + ldsw + _i * 8192), 16, 0, 0); } while (0)
#define PG8_STAGE_A(bufoff, ubase, vg, h, kb) do { if constexpr (Sched::GATHER) PG8_STAGE(bufoff, (const char*)g.A + (kb), (vg)[h]); else PG8_STAGE(bufoff, (ubase) + (h) * hstep + (kb), voffA); } while (0)
#define PG8_LDA(dst, b, h) do { _Pragma("unroll") for (int m = 0; m < 4; ++m) _Pragma("unroll") for (int k = 0; k < 2; ++k) dst[m][k] = *(const LAS bf16x8*)(lds + PG8_SA(b, h) + aoff + m * 2048 + k * 1024); } while (0)
#define PG8_LDB(dst, b, h) do { _Pragma("unroll") for (int n = 0; n < 2; ++n) _Pragma("unroll") for (int k = 0; k < 2; ++k) dst[n][k] = *(const LAS bf16x8*)(lds + PG8_SB(b, h) + boff + n * 2048 + k * 1024); } while (0)
#define PG8_MMA(ai, bj, At, Bt) do { __builtin_amdgcn_s_setprio(1); _Pragma("unroll") for (int m = 0; m < 4; ++m) _Pragma("unroll") for (int n = 0; n < 2; ++n) _Pragma("unroll") for (int k = 0; k < 2; ++k) \
        acc[ai][bj][m][n] = __builtin_amdgcn_mfma_f32_16x16x32_bf16(Bt[n][k], At[m][k], acc[ai][bj][m][n], 0, 0, 0); __builtin_amdgcn_s_setprio(0); } while (0)
#define PG8_WAIT_V(n) asm volatile("s_waitcnt vmcnt(" #n ")" ::: "memory")
#define PG8_WAIT_L(n) asm volatile("s_waitcnt lgkmcnt(" #n ")" ::: "memory")
#define PG8_BAR __builtin_amdgcn_s_barrier()
#define PG8_SCHED __builtin_amdgcn_sched_barrier(0)
#define PG8_UNI(u) do { (u).pm = __builtin_amdgcn_readfirstlane((u).pm); (u).pn = __builtin_amdgcn_readfirstlane((u).pn); (u).ax = __builtin_amdgcn_readfirstlane((u).ax); (u).ax2 = __builtin_amdgcn_readfirstlane((u).ax2); } while (0)
#define PG8_FILL(v, u) do { _Pragma("unroll") for (int _h = 0; _h < 2; ++_h) _Pragma("unroll") for (int _i = 0; _i < 2; ++_i) \
        (v)[_h][_i] = (unsigned)(S.row_src((u), _h * HALF + stR[_i]) * K + stC[_i]) * 2u; } while (0)
    Unit cur, nxt; int ui = 0;
    if (!S.next(0, cur)) return;
    PG8_UNI(cur);
    f32x4 acc[2][2][4][2];
#pragma unroll
    for (int a = 0; a < 2; ++a)
#pragma unroll
        for (int b = 0; b < 2; ++b)
#pragma unroll
            for (int m = 0; m < 4; ++m)
#pragma unroll
                for (int n = 0; n < 2; ++n) acc[a][b][m][n] = (f32x4){0.f, 0.f, 0.f, 0.f};
    bf16x8 At[4][2], B0[2][2], B1[2][2];
    unsigned vAc[2][2] = {{0u, 0u}, {0u, 0u}}, vAn[2][2] = {{0u, 0u}, {0u, 0u}}, vA2[2][2] = {{0u, 0u}, {0u, 0u}};
    if constexpr (Sched::GATHER) PG8_FILL(vAc, cur);
    const char* cA = (const char*)g.A + (Sched::GATHER ? (size_t)0 : (size_t)cur.pm * tstep); const char* cB = (const char*)g.Bt + (size_t)cur.pn * tstep;
    PG8_STAGE(PG8_SB(0, 0), cB, voffB); PG8_STAGE(PG8_SB(0, 1), cB + hstep, voffB); PG8_STAGE_A(PG8_SA(0, 0), cA, vAc, 0, (size_t)0); PG8_STAGE_A(PG8_SA(0, 1), cA, vAc, 1, (size_t)0);
    if (wr == 1) PG8_BAR;
    PG8_WAIT_V(2); PG8_BAR;
    PG8_STAGE(PG8_SB(1, 0), cB + kstep, voffB); PG8_STAGE_A(PG8_SA(1, 0), cA, vAc, 0, kstep); PG8_STAGE(PG8_SB(1, 1), cB + hstep + kstep, voffB);
    PG8_WAIT_V(6); PG8_BAR;
    for (;;) {
        bool has_next = S.next(ui + 1, nxt);
        has_next = __builtin_amdgcn_readfirstlane((int)has_next) != 0;
        if (has_next) { PG8_UNI(nxt); if constexpr (Sched::GATHER) PG8_FILL(vAn, nxt); }
        const char* nA = (has_next && !Sched::GATHER) ? (const char*)g.A + (size_t)nxt.pm * tstep : cA; const char* nB = has_next ? (const char*)g.Bt + (size_t)nxt.pn * tstep : cB;
        for (int t = 0; t < nt; t += 2) {
            const bool last = (t == nt - 2);
            const size_t k1 = (size_t)(t + 1) * kstep;
            const size_t k2 = last ? (size_t)0 : (size_t)(t + 2) * kstep, k3 = k2 + kstep;
            const char* a2 = last ? nA : cA; const char* b2 = (last ? nB : cB) + k2; const char* b3 = b2 + kstep;
            if constexpr (Sched::GATHER) {
#pragma unroll
                for (int h = 0; h < 2; ++h)
#pragma unroll
                    for (int i = 0; i < 2; ++i) vA2[h][i] = (last && has_next) ? vAn[h][i] : vAc[h][i];
            }
            PG8_LDB(B0, 0, 0); PG8_LDB(B1, 0, 1); PG8_SCHED; PG8_LDA(At, 0, 0); PG8_STAGE_A(PG8_SA(1, 1), cA, vAc, 1, k1);
            PG8_WAIT_V(8); PG8_WAIT_L(0); PG8_BAR; PG8_MMA(0, 0, At, B0); PG8_MMA(0, 1, At, B1); PG8_BAR; PG8_SCHED;
            PG8_LDA(At, 0, 1); PG8_STAGE(PG8_SB(0, 0), b2, voffB); PG8_STAGE(PG8_SB(0, 1), b2 + hstep, voffB); PG8_STAGE_A(PG8_SA(0, 0), a2, vA2, 0, k2);
            PG8_WAIT_V(8); PG8_WAIT_L(0); PG8_BAR; PG8_MMA(1, 0, At, B0); PG8_MMA(1, 1, At, B1); PG8_BAR; PG8_SCHED;
            PG8_LDB(B0, 1, 0); PG8_LDB(B1, 1, 1); PG8_SCHED; PG8_LDA(At, 1, 0); PG8_STAGE_A(PG8_SA(0, 1), a2, vA2, 1, k2);
            PG8_WAIT_V(8); PG8_WAIT_L(0); PG8_BAR; PG8_MMA(0, 0, At, B0); PG8_MMA(0, 1, At, B1); PG8_BAR; PG8_SCHED;
            PG8_LDA(At, 1, 1); PG8_STAGE(PG8_SB(1, 0), b3, voffB); PG8_STAGE(PG8_SB(1, 1), b3 + hstep, voffB); PG8_STAGE_A(PG8_SA(1, 0), a2, vA2, 0, k3);
            PG8_WAIT_V(8); PG8_WAIT_L(0); PG8_BAR; PG8_MMA(1, 0, At, B0); PG8_MMA(1, 1, At, B1); PG8_BAR; PG8_SCHED;
        }
        if constexpr (ALIGN_EPI) { if (wr == 0) PG8_BAR; }
        E(acc, cur, wr, wc, fr, fq);
        if (!has_next) break;
        if (!(Epi::KEEP && E.keep(cur))) {
#pragma unroll
            for (int a = 0; a < 2; ++a)
#pragma unroll
                for (int b = 0; b < 2; ++b)
#pragma unroll
                    for (int m = 0; m < 4; ++m)
#pragma unroll
                        for (int n = 0; n < 2; ++n) acc[a][b][m][n] = (f32x4){0.f, 0.f, 0.f, 0.f};
        }
        cur = nxt; cA = nA; cB = nB; ++ui;
        if constexpr (Sched::GATHER) {
#pragma unroll
            for (int h = 0; h < 2; ++h)
#pragma unroll
                for (int i = 0; i < 2; ++i) vAc[h][i] = vAn[h][i];
        }
        if constexpr (ALIGN_EPI) { if (wr == 1) PG8_BAR; }
    }
    PG8_WAIT_V(0);
    if constexpr (!ALIGN_EPI) { if (wr == 0) PG8_BAR; }
    PG8_BAR;
#undef PG8_SA
#undef PG8_SB
#undef PG8_STAGE
#undef PG8_STAGE_A
#undef PG8_LDA
#undef PG8_LDB
#undef PG8_MMA
#undef PG8_WAIT_V
#undef PG8_WAIT_L
#undef PG8_BAR
#undef PG8_SCHED
#undef PG8_UNI
#undef PG8_FILL
}
}

#define XB_TMO      128
#define XB_XCNT(j)  (256  + 64 * (j))
#define XB_XSUB(j)  (1280 + 64 * (j))
#define XB_XGEN(j)  (2304 + 64 * (j))
#define XB_TOP      3328
#define XB_TOPGEN   3392
#define XCD_BAR_WORDS 3456
#define XB_SPIN_CAP (1u << 18)
__device__ __forceinline__ unsigned xb_ld(unsigned* p)              { return __hip_atomic_load(p, __ATOMIC_RELAXED, __HIP_MEMORY_SCOPE_AGENT); }
__device__ __forceinline__ unsigned xb_add(unsigned* p, unsigned v) { return __hip_atomic_fetch_add(p, v, __ATOMIC_RELAXED, __HIP_MEMORY_SCOPE_AGENT); }
__device__ __forceinline__ unsigned xb_xcc_id() { return (unsigned)__builtin_amdgcn_s_getreg((3 << 11) | 20) & 0xFu; }
#define XB_SPIN(cond, bar) do { unsigned _sp = 0; while (cond) { __builtin_amdgcn_s_sleep(1); \
    if ((++_sp & 255u) == 0u) { if (xb_ld(&(bar)[XB_TMO])) break; if (_sp > XB_SPIN_CAP) { atomicAdd(&(bar)[XB_TMO], 1u); break; } } } } while (0)
struct XcdBarrier { unsigned* bar; unsigned x; volatile LAS unsigned* st; };
__device__ __forceinline__ XcdBarrier xcd_barrier_post(unsigned* bar, volatile LAS unsigned* st) {
    XcdBarrier b; b.bar = bar; b.x = xb_xcc_id(); b.st = st;
    if (threadIdx.x == 0) (void)xb_add(&bar[XB_XCNT(b.x)], 1u);
    return b;
}
__device__ __forceinline__ void xcd_barrier_complete(unsigned* bar, unsigned x, unsigned& nloc, unsigned& nx) {
    const unsigned G = gridDim.x * gridDim.y * gridDim.z;
    unsigned sum, cnt, mine, sp = 0u;
    for (;;) {
        sum = 0u; cnt = 0u; mine = 0u;
#pragma unroll
        for (unsigned j = 0; j < 16; ++j) { const unsigned c = xb_ld(&bar[XB_XCNT(j)]); sum += c; cnt += (c > 0u) ? 1u : 0u; mine = (j == x) ? c : mine; }
        if (sum == G) break;
        __builtin_amdgcn_s_sleep(1);
        if ((++sp & 255u) == 0u) { if (xb_ld(&bar[XB_TMO])) break; if (sp > XB_SPIN_CAP) { atomicAdd(&bar[XB_TMO], 1u); break; } }
    }
    nloc = mine > 0u ? mine : 1u; nx = cnt > 0u ? cnt : 1u;
}
__device__ __forceinline__ void xcd_barrier(const XcdBarrier& b) {
    asm volatile("s_waitcnt vmcnt(0)" ::: "memory");
    __syncthreads();
    if (threadIdx.x == 0) {
        unsigned* bar = b.bar;
        __builtin_amdgcn_s_waitcnt(0);
        unsigned nloc = b.st[0], nx = b.st[1];
        if (nloc == 0u) { xcd_barrier_complete(bar, b.x, nloc, nx); b.st[0] = nloc; b.st[1] = nx; }
        const unsigned old = xb_add(&bar[XB_XSUB(b.x)], 1u);
        const unsigned gen = old / nloc;
        if (old + 1u == (gen + 1u) * nloc) {
            __builtin_amdgcn_fence(__ATOMIC_RELEASE, "agent");
            asm volatile("s_waitcnt vmcnt(0)" ::: "memory");
            const unsigned og = xb_add(&bar[XB_TOP], 1u);
            const unsigned tg = og / nx;
            if (og + 1u == (tg + 1u) * nx) xb_add(&bar[XB_TOPGEN], 1u);
            else XB_SPIN(xb_ld(&bar[XB_TOPGEN]) == tg, bar);
            __builtin_amdgcn_fence(__ATOMIC_ACQUIRE, "agent");
            xb_add(&bar[XB_XGEN(b.x)], 1u);
            asm volatile("s_waitcnt vmcnt(0)" ::: "memory");
        } else {
            XB_SPIN(xb_ld(&bar[XB_XGEN(b.x)]) == gen, bar);
            __builtin_amdgcn_fence(__ATOMIC_ACQUIRE, "agent");
            asm volatile("s_waitcnt vmcnt(0)" ::: "memory");
        }
    }
    __syncthreads();
}

__device__ __forceinline__ void transpose_item(const float* W, int K, int N, bf16_t* WT, int k0, int n0, int dst_off, LAS float* scr, int lane) {
#pragma unroll 8
    for (int i = 0; i < 32; ++i) { const int kk = 2 * i + (lane >> 5); scr[kk * 33 + (lane & 31)] = W[(size_t)(k0 + kk) * N + n0 + (lane & 31)]; }
    LDS_WAIT(); asm volatile("" ::: "memory");
    const int c = lane & 7;
#pragma unroll
    for (int j = 0; j < 4; ++j) { const int n = (lane >> 3) + 8 * j; const LAS float* s = scr + (8 * c) * 33 + n;
        u32x4 o; o.x = pk2(s[0 * 33], s[1 * 33]); o.y = pk2(s[2 * 33], s[3 * 33]); o.z = pk2(s[4 * 33], s[5 * 33]); o.w = pk2(s[6 * 33], s[7 * 33]);
        *(u32x4*)(WT + (size_t)(dst_off + n0 + n) * K + k0 + 8 * c) = o; }
    LDS_WAIT(); asm volatile("" ::: "memory");
}
__device__ __forceinline__ int win_dst(int n0) {
    if (n0 < 2048) return n0;
    if (n0 < 3072) return 7168 + (n0 - 2048);
    if (n0 < 4096) return 2048 + (n0 - 3072);
    if (n0 < 5120) return 8192 + (n0 - 4096);
    return 3072 + (n0 - 5120);
}

__device__ __forceinline__ int crow(int r, int hi) { return (r & 3) + 8 * (r >> 2) + 4 * hi; }
__device__ __forceinline__ void sb_attn_unit(int b, int h, int qb, const bf16_t* Q, const bf16_t* Kb, const bf16_t* VT, bf16_t* Oa, int lane) {
    const int r32 = lane & 31, hi = lane >> 5;
    const size_t tok0 = (size_t)b * SEQ;
    bf16x8 qf[8];
    { const bf16_t* qp = Q + (tok0 + (size_t)qb * 32 + r32) * SBW + h * HD + 8 * hi;
#pragma unroll
      for (int st = 0; st < 8; ++st) qf[st] = *(const bf16x8*)(qp + 16 * st); }
    f32x16 o[4];
#pragma unroll
    for (int d = 0; d < 4; ++d)
#pragma unroll
        for (int r = 0; r < 16; ++r) o[d][r] = 0.f;
    float carry = 0.f;
    for (int kb = qb; kb >= 0; --kb) {
        const size_t mk = tok0 + (size_t)kb * 32;
        bf16x8 kf[8];
        { const bf16_t* kp = Kb + (mk + r32) * SBW + h * HD + 8 * hi;
#pragma unroll
          for (int st = 0; st < 8; ++st) kf[st] = *(const bf16x8*)(kp + 16 * st); }
        s16x4 vlo[4][2], vhi[4][2];
        { const bf16_t* vp = VT + (size_t)(h * HD + r32) * M + mk + 4 * hi;
#pragma unroll
          for (int d = 0; d < 4; ++d)
#pragma unroll
              for (int s = 0; s < 2; ++s) { vlo[d][s] = *(const s16x4*)(vp + (size_t)(d * 32) * M + 16 * s); vhi[d][s] = *(const s16x4*)(vp + (size_t)(d * 32) * M + 16 * s + 8); } }
        f32x16 sc;
#pragma unroll
        for (int r = 0; r < 16; ++r) sc[r] = 0.f;
#pragma unroll
        for (int st = 0; st < 8; ++st) sc = __builtin_amdgcn_mfma_f32_32x32x16_bf16(kf[st], qf[st], sc, 0, 0, 0);
        const bool diag = (kb == qb);
        float L[16];
#pragma unroll
        for (int r = 0; r < 16; ++r) {
            const float z = sc[r];
            const float sp = fmaxf(z, 0.f) + __builtin_amdgcn_logf(1.0f + __builtin_amdgcn_exp2f(-fabsf(z)));
            const bool valid = !diag || (crow(r, hi) < r32);
            L[r] = valid ? -sp : 0.f;
        }
        float Gs[4], Gp[4], T[4];
#pragma unroll
        for (int g = 0; g < 4; ++g) { L[4 * g + 2] += L[4 * g + 3]; L[4 * g + 1] += L[4 * g + 2]; L[4 * g] += L[4 * g + 1]; Gs[g] = L[4 * g]; }
#pragma unroll
        for (int g = 0; g < 4; ++g) { Gp[g] = __shfl_xor(Gs[g], 32); T[g] = Gs[g] + Gp[g]; }
        float Aft[4]; Aft[3] = 0.f; Aft[2] = T[3]; Aft[1] = Aft[2] + T[2]; Aft[0] = Aft[1] + T[1];
        f32x16 p;
#pragma unroll
        for (int g = 0; g < 4; ++g) { const float add = Aft[g] + (hi == 0 ? Gp[g] : 0.f) + carry;
#pragma unroll
            for (int i = 0; i < 4; ++i) { const int r = 4 * g + i; const bool valid = !diag || (crow(r, hi) < r32);
                p[r] = valid ? __builtin_amdgcn_exp2f(sc[r] + L[r] + add) : 0.f; } }
        carry += Aft[0] + T[0];
#pragma unroll
        for (int s = 0; s < 2; ++s) {
            u32x4 pp; pp.x = pk2(p[8 * s], p[8 * s + 1]); pp.y = pk2(p[8 * s + 2], p[8 * s + 3]); pp.z = pk2(p[8 * s + 4], p[8 * s + 5]); pp.w = pk2(p[8 * s + 6], p[8 * s + 7]);
            const bf16x8 pf = __builtin_bit_cast(bf16x8, pp);
#pragma unroll
            for (int d = 0; d < 4; ++d) { const bf16x8 vf = __builtin_shufflevector(vlo[d][s], vhi[d][s], 0, 1, 2, 3, 4, 5, 6, 7);
                o[d] = __builtin_amdgcn_mfma_f32_32x32x16_bf16(pf, vf, o[d], 0, 0, 0); }
        }
        if (__builtin_amdgcn_ballot_w64(carry >= -64.0f) == 0ull) break;
    }
    bf16_t* op = Oa + (tok0 + (size_t)qb * 32) * SBW + h * HD + r32;
#pragma unroll
    for (int d = 0; d < 4; ++d)
#pragma unroll
        for (int r = 0; r < 16; ++r) op[(size_t)crow(r, hi) * SBW + d * 32] = (bf16_t)f2bf(o[d][r]);
}

__device__ __forceinline__ void sgu_item(int blk, int half, const bf16_t* SVT  , const bf16_t* SU, const float* sgu_w, const float* sgu_b,
                                         const float* lng, const float* lnb, bf16_t* Ob, LAS unsigned char* lds, int tid) {
    const int lane = tid & 63, wave = tid >> 6, r32 = lane & 31, hi = lane >> 5;
    const size_t m0 = (size_t)blk * 128;
    LAS float* part = (LAS float*)lds;
    LAS float* mu = part + 2048;
    LAS float* rs = mu + 128;
    LAS float* cw = rs + 128;
    { float sa = 0.f, qa = 0.f, sb = 0.f, qb = 0.f;
      const unsigned* src = (const unsigned*)(SVT + (size_t)wave * M + m0) + lane;
#pragma unroll 8
      for (int i = 0; i < 128; ++i) { const unsigned u = src[(size_t)i * 8 * (M / 2)]; const float x0 = bflo(u), x1 = bfhi(u); sa += x0; qa += x0 * x0; sb += x1; qb += x1 * x1; }
      part[(wave * 128 + 2 * lane) * 2 + 0] = sa; part[(wave * 128 + 2 * lane) * 2 + 1] = qa;
      part[(wave * 128 + 2 * lane + 1) * 2 + 0] = sb; part[(wave * 128 + 2 * lane + 1) * 2 + 1] = qb; }
    __syncthreads();
    if (tid < 128) { float s = 0.f, q = 0.f;
#pragma unroll
        for (int w = 0; w < 8; ++w) { s += part[(w * 128 + tid) * 2]; q += part[(w * 128 + tid) * 2 + 1]; }
        const float mean = s * (1.0f / 1024.0f); const float var = fmaxf(q * (1.0f / 1024.0f) - mean * mean, 0.f);
        mu[tid] = mean; rs[tid] = 1.0f / sqrtf(var + LN_EPS); }
    __syncthreads();
    const int g = half * 4 + (wave >> 1), th = wave & 1, nks = th ? 8 : 4;
    LAS float* c1s = cw + wave * 64; LAS float* c2s = c1s + 32;
    for (int tb = 0; tb < 2; ++tb) {
        const int t0 = th * 64 + tb * 32;
        f32x16 acc[4];
#pragma unroll
        for (int d = 0; d < 4; ++d)
#pragma unroll
            for (int r = 0; r < 16; ++r) acc[d][r] = 0.f;
        float c1 = 0.f, c2 = 0.f;
        const float* wrow = sgu_w + ((size_t)g * 128 + t0 + r32) * 128 + 8 * hi;
        const bf16_t* vb = SVT + (size_t)(g * 128 + r32) * M + m0 + 8 * hi;
        for (int ks = 0; ks < nks; ++ks) {
            const f32x4 w0 = *(const f32x4*)(wrow + 16 * ks), w1 = *(const f32x4*)(wrow + 16 * ks + 4);
            const int k0 = 16 * ks + 8 * hi;
            float wv[8] = {w0[0], w0[1], w0[2], w0[3], w1[0], w1[1], w1[2], w1[3]}, wp[8];
#pragma unroll
            for (int j = 0; j < 8; ++j) { wp[j] = wv[j] * rs[k0 + j]; c1 += wp[j] * mu[k0 + j]; c2 += wv[j]; }
            u32x4 ap; ap.x = pk2(wp[0], wp[1]); ap.y = pk2(wp[2], wp[3]); ap.z = pk2(wp[4], wp[5]); ap.w = pk2(wp[6], wp[7]);
            const bf16x8 af = __builtin_bit_cast(bf16x8, ap);
#pragma unroll
            for (int d = 0; d < 4; ++d) { const bf16x8 bf = *(const bf16x8*)(vb + (size_t)(d * 32) * M + 16 * ks);
                acc[d] = __builtin_amdgcn_mfma_f32_32x32x16_bf16(af, bf, acc[d], 0, 0, 0); }
        }
        c1 += __shfl_xor(c1, 32); c2 += __shfl_xor(c2, 32);
        if (hi == 0) { c1s[r32] = c1; c2s[r32] = c2; }
        LDS_WAIT(); asm volatile("" ::: "memory");
#pragma unroll
        for (int d = 0; d < 4; ++d) { const int ch = g * 128 + d * 32 + r32; const float gn = lng[ch], bs = lnb[ch];
#pragma unroll
            for (int r = 0; r < 16; ++r) { const int tl = crow(r, hi), t = t0 + tl;
                const float mixed = gn * (acc[d][r] - c1s[tl]) + bs * c2s[tl] + sgu_b[g * 128 + t];
                const size_t o = (m0 + t) * SGW + ch;
                const float uu = __uint_as_float((unsigned)SU[o] << 16);
                Ob[o] = (bf16_t)f2bf(uu * mixed); } }
        LDS_WAIT(); asm volatile("" ::: "memory");
    }
    __syncthreads();
}

struct Args { const float* in[23]; float* out; unsigned char* ws; int ph_lo, ph_hi; };
constexpr int NPHASE = 10;

__global__ void __launch_bounds__(NWAVES * 64, 2) mk_fwd(Args args) {
    extern __shared__ __attribute__((aligned(16))) unsigned char lds_raw[];
    LAS unsigned char* lds = (LAS unsigned char*)lds_raw;
    volatile LAS unsigned* MISC = (volatile LAS unsigned*)(lds + MISC_OFF);
    const int tid = threadIdx.x, lane = tid & 63, wave = __builtin_amdgcn_readfirstlane(tid >> 6);
    const int G = gridDim.x, bx = blockIdx.x;
    const int vcu = (G % 8 == 0) ? (bx % 8) * (G / 8) + bx / 8 : bx;
    const int gw = vcu * NWAVES + wave, NGW = G * NWAVES;
    unsigned char* ws = args.ws;
    unsigned* ctl = (unsigned*)(ws + WS_CTL);
    const float* x = args.in[0]; const float* cvec = args.in[1]; const float* w_ada = args.in[2]; const float* b_ada = args.in[3]; const float* w_in = args.in[4];
    const float* sgu_w = args.in[5]; const float* sgu_b = args.in[6]; const float* sgu_lng = args.in[7]; const float* sgu_lnb = args.in[8];
    const float* w_pa = args.in[9]; const float* w_pb = args.in[10]; const float* w_out = args.in[11]; const float* ln1g = args.in[12]; const float* ln1b = args.in[13];
    const float* w_group = args.in[14]; const float* b_group = args.in[15]; const float* w_router = args.in[16]; const float* b_router = args.in[17];
    const float* w_gate = args.in[18]; const float* w_up = args.in[19]; const float* w_down = args.in[20]; const float* ln2g = args.in[21]; const float* ln2b = args.in[22];
    float* modp = (float*)(ws + WS_MODP); float* mod = (float*)(ws + WS_MOD);
    int* toklist = (int*)(ws + WS_TOK); int* asg = (int*)(ws + WS_ASG);
    bf16_t* Wab = (bf16_t*)(ws + WS_WAB); bf16_t* Wout = (bf16_t*)(ws + WS_WOUT); bf16_t* Wgu = (bf16_t*)(ws + WS_WGU); bf16_t* Wd = (bf16_t*)(ws + WS_WD); bf16_t* Win = (bf16_t*)(ws + WS_WIN);
    bf16_t* Hb = (bf16_t*)(ws + WS_H); bf16_t* Qb = (bf16_t*)(ws + WS_Q); bf16_t* Kb = (bf16_t*)(ws + WS_K); bf16_t* SUb = (bf16_t*)(ws + WS_SU); bf16_t* VTb = (bf16_t*)(ws + WS_VT);
    bf16_t* MRG = (bf16_t*)(ws + WS_MRG); bf16_t* YS = (bf16_t*)(ws + WS_YS); bf16_t* SAb = (bf16_t*)(ws + WS_SA); bf16_t* SBb = (bf16_t*)(ws + WS_SB);
    float* V1 = (float*)(ws + WS_V1); bf16_t* OAB = (bf16_t*)(ws + WS_OAB); bf16_t* HBb = (bf16_t*)(ws + WS_HB);

    for (int u = tid; u < (LDS_BYTES - LDSCTL_OFF) / 4; u += NWAVES * 64) ((LAS unsigned*)(lds + LDSCTL_OFF))[u] = 0u;
    __syncthreads();
    XcdBarrier bar; bar.bar = ctl + CW_BAR; bar.x = 0; bar.st = nullptr;
#if !MK_PER_PHASE
    bar = xcd_barrier_post(ctl + CW_BAR, MISC + 8);
#define GRID_BAR() xcd_barrier(bar)
#else
#define GRID_BAR() do { } while (0)
#endif
    const int lo = args.ph_lo, hi_ph = args.ph_hi;
#ifndef PH_MASK
#define PH_MASK 0x3ff
#endif
#define IN(k) (((PH_MASK >> (k)) & 1) && lo <= (k) && (k) < hi_ph)
#define BOTH(k) (IN(k) && IN((k) + 1))

    if (IN(0)) {
        LAS float* sl = (LAS float*)lds;
        for (int item = vcu; item < 256; item += G) {
            const int cc = item & 31, ks = item >> 5;
            { const int b = tid >> 8, kk = tid & 255; const float v = cvec[b * DM + ks * 256 + kk]; sl[tid] = v / (1.0f + __expf(-v)); }
            __syncthreads();
            const int cg = tid % 96, sub = tid / 96;
            f32x4 a0 = {0.f, 0.f, 0.f, 0.f}, a1 = {0.f, 0.f, 0.f, 0.f};
            if (sub < 4) {
                const float* wp = w_ada + (size_t)(ks * 256 + sub * 64) * MODW + cc * 384 + cg * 4;
#pragma unroll 8
                for (int i = 0; i < 64; ++i) { const f32x4 w = *(const f32x4*)(wp + (size_t)i * MODW); a0 += w * sl[sub * 64 + i]; a1 += w * sl[256 + sub * 64 + i]; }
            }
            LAS float* red = sl + 512;
            if (sub < 4) { *(LAS f32x4*)(red + (sub * 2 + 0) * 384 + cg * 4) = a0; *(LAS f32x4*)(red + (sub * 2 + 1) * 384 + cg * 4) = a1; }
            __syncthreads();
            if (tid < 192) { const int b = tid / 96, gq = tid % 96; f32x4 s = {0.f, 0.f, 0.f, 0.f};
#pragma unroll
                for (int sb = 0; sb < 4; ++sb) s += *(LAS f32x4*)(red + (sb * 2 + b) * 384 + gq * 4);
                *(f32x4*)(modp + ((size_t)ks * 2 + b) * MODW + cc * 384 + gq * 4) = s; }
            __syncthreads();
        }
        LAS float* scr = (LAS float*)(lds + wave * 16384);
        constexpr int I_IN = 32 * 288, I_P = 16 * 64, I_O = 32 * 64, I_G = 32 * 16  , I_D = 8 * 64  ;
        constexpr int NITEMS = I_IN + 2 * I_P + I_O + NE * (2 * I_G + I_D);
        for (int it = gw; it < NITEMS; it += NGW) {
            int r = it;
            if (r < I_IN) { const int kb = r / 288, nb = r % 288; transpose_item(w_in, DM, INC, Win, 64 * kb, 32 * nb, win_dst(32 * nb) - 32 * nb, scr, lane); continue; } r -= I_IN;
            if (r < I_P) { const int kb = r / 64, nb = r % 64; transpose_item(w_pa, 1024, DM, Wab, 64 * kb, 32 * nb, 0, scr, lane); continue; } r -= I_P;
            if (r < I_P) { const int kb = r / 64, nb = r % 64; transpose_item(w_pb, 1024, DM, Wab, 64 * kb, 32 * nb, 2048, scr, lane); continue; } r -= I_P;
            if (r < I_O) { const int kb = r / 64, nb = r % 64; transpose_item(w_out, DM, DM, Wout, 64 * kb, 32 * nb, 0, scr, lane); continue; } r -= I_O;
            if (r < NE * I_G) { const int e = r / I_G, q = r % I_G, kb = q / 16, nb = q % 16, n0 = 32 * nb;
                transpose_item(w_gate + (size_t)e * DM * DE, DM, DE, Wgu + (size_t)e * 1024 * DM, 64 * kb, n0, 128 * (n0 / 128), scr, lane); continue; } r -= NE * I_G;
            if (r < NE * I_G) { const int e = r / I_G, q = r % I_G, kb = q / 16, nb = q % 16, n0 = 32 * nb;
                transpose_item(w_up + (size_t)e * DM * DE, DM, DE, Wgu + (size_t)e * 1024 * DM, 64 * kb, n0, 128 * (n0 / 128) + 128, scr, lane); continue; } r -= NE * I_G;
            { const int e = r / I_D, q = r % I_D, kb = q / 64, nb = q % 64;
                transpose_item(w_down + (size_t)e * DE * DM, DE, DM, Wd + (size_t)e * DM * DE, 64 * kb, 32 * nb, 0, scr, lane); }
        }
        if (BOTH(0)) GRID_BAR();
    }

    if (IN(1)) {
        LAS float* ms = (LAS float*)lds;
        for (int idx = tid; idx < 8192; idx += NWAVES * 64) { const int b = idx >> 12, j = idx & 4095; float v = b_ada[j];
#pragma unroll
            for (int p = 0; p < 8; ++p) v += modp[((size_t)p * 2 + b) * MODW + j];
            ms[idx] = (j >= DM) ? 1.0f + v : v; }
        for (int idx = vcu * (NWAVES * 64) + tid; idx < 2 * MODW; idx += G * NWAVES * 64) { const int b = idx / MODW, j = idx % MODW; float v = b_ada[j];
#pragma unroll
            for (int p = 0; p < 8; ++p) v += modp[((size_t)p * 2 + b) * MODW + j];
            mod[idx] = v; }
        __syncthreads();
        for (int m = gw; m < M; m += NGW) {
            const int b = m >> 13;
            const f32x4* xr = (const f32x4*)(x + (size_t)m * DM) + lane;
            f32x4 v[8]; float s = 0.f;
#pragma unroll
            for (int j = 0; j < 8; ++j) { v[j] = xr[64 * j]; s += (v[j].x + v[j].y) + (v[j].z + v[j].w); }
            const float mean = wave_sum(s) * (1.0f / DM); float s2 = 0.f;
#pragma unroll
            for (int j = 0; j < 8; ++j) { v[j] = v[j] - mean; s2 += (v[j].x * v[j].x + v[j].y * v[j].y) + (v[j].z * v[j].z + v[j].w * v[j].w); }
            const float rstd = 1.0f / sqrtf(wave_sum(s2) * (1.0f / DM) + LN_EPS);
            u32x2* o8 = (u32x2*)(Hb + (size_t)m * DM) + lane;
#pragma unroll
            for (int j = 0; j < 8; ++j) { const f32x4 sh = *(const LAS f32x4*)(ms + (b * 2) * DM + 256 * j + 4 * lane), sc = *(const LAS f32x4*)(ms + (b * 2 + 1) * DM + 256 * j + 4 * lane);
                const f32x4 hv = v[j] * rstd * sc + sh; u32x2 w; w.x = pk2(hv.x, hv.y); w.y = pk2(hv.z, hv.w); o8[64 * j] = w; }
        }
        __syncthreads();
        if (BOTH(1)) GRID_BAR();
    }

    if (IN(2)) {
        { pg8::Gemm g{Hb, Win, DM}; pg8::StaticOrder S; S.init(M, N1, G, bx);
          pg8::EpiG1 E{Qb, Kb, SUb, SAb, SBb};
          pg8::gemm_phase<pg8::EpiG1, pg8::StaticOrder, true>(lds, g, S, E); }
        { pg8::Gemm g{Win + (size_t)N1 * DM, Hb, DM}; pg8::StaticOrder S; S.init(2048, M, G, bx);
          pg8::EpiG2 E{VTb};
          pg8::gemm_phase<pg8::EpiG2, pg8::StaticOrder, true>(lds, g, S, E); }
        if (BOTH(2)) GRID_BAR();
    }

    if (IN(3)) {
        for (int item = vcu; item < 256; item += G)
            sgu_item(item >> 1, item & 1, VTb + (size_t)1024 * M, SUb, sgu_w, sgu_b, sgu_lng, sgu_lnb, OAB + (size_t)M * SBW, lds, tid);
        for (int U = gw; U < BATCH * NHEAD * (SEQ / 32); U += NGW) {
            const int bh = U >> 8, qb = U & 255;
            sb_attn_unit(bh >> 3, bh & 7, qb, Qb, Kb, VTb, OAB, lane);
        }
        if (BOTH(3)) GRID_BAR();
    }

    if (IN(4)) {
        pg8::Gemm g{OAB, Wab, 1024}; pg8::PairOrder S; S.so.init(M, DM, G, bx);
        pg8::EpiGate E{SAb, SBb, MRG};
        pg8::gemm_phase<pg8::EpiGate, pg8::PairOrder, true>(lds, g, S, E);
        if (BOTH(4)) GRID_BAR();
    }

    if (IN(5)) {
        pg8::Gemm g{MRG, Wout, DM}; pg8::StaticOrder S; S.init(M, DM, G, bx);
        pg8::EpiV1 E{x, mod, V1};
        pg8::gemm_phase<pg8::EpiV1, pg8::StaticOrder, true>(lds, g, S, E);
        if (BOTH(5)) GRID_BAR();
    }

    if (IN(6)) {
        LAS float* wl = (LAS float*)lds;
        for (int it = vcu; it < M / 16; it += G) {
            const int mbase = it * 16 + wave * 2;
            float mean2[2], rstd2[2];
#pragma unroll
            for (int rr = 0; rr < 2; ++rr) {
                const int m = mbase + rr, b = m >> 13;
                int lane_o = lane; asm volatile("" : "+v"(lane_o));
                f32x2* vr = (f32x2*)(V1 + (size_t)m * DM) + lane_o;
                f32x2 v[16]; float s = 0.f;
#pragma unroll
                for (int j = 0; j < 16; ++j) { v[j] = vr[64 * j]; s += v[j].x + v[j].y; }
                float mean = wave_sum(s) * (1.0f / DM); float s2 = 0.f;
#pragma unroll
                for (int j = 0; j < 16; ++j) { v[j] = v[j] - mean; s2 += v[j].x * v[j].x + v[j].y * v[j].y; }
                float rstd = 1.0f / sqrtf(wave_sum(s2) * (1.0f / DM) + LN_EPS);
                s = 0.f;
#pragma unroll
                for (int j = 0; j < 16; ++j) { const f32x2 gq = *((const f32x2*)ln1g + 64 * j + lane_o), bq = *((const f32x2*)ln1b + 64 * j + lane_o);
                    v[j] = v[j] * rstd * gq + bq; vr[64 * j] = v[j]; s += v[j].x + v[j].y; }
                mean = wave_sum(s) * (1.0f / DM); s2 = 0.f;
#pragma unroll
                for (int j = 0; j < 16; ++j) { const f32x2 d = v[j] - mean; s2 += d.x * d.x + d.y * d.y; }
                rstd = 1.0f / sqrtf(wave_sum(s2) * (1.0f / DM) + LN_EPS);
                mean2[rr] = mean; rstd2[rr] = rstd;
                const f32x2* sh2 = (const f32x2*)(mod + (size_t)b * MODW + 3 * DM); const f32x2* sc2 = (const f32x2*)(mod + (size_t)b * MODW + 4 * DM);
                unsigned* ho = (unsigned*)(Hb + (size_t)m * DM) + lane_o;
#pragma unroll
                for (int j = 0; j < 16; ++j) { const f32x2 a = sh2[64 * j + lane_o], c = sc2[64 * j + lane_o];
                    const f32x2 hv = (v[j] - mean) * rstd * (c + 1.0f) + a; ho[64 * j] = pk2(hv.x, hv.y); }
            }
            float lg[2][36];
#pragma unroll
            for (int rr = 0; rr < 2; ++rr)
#pragma unroll
                for (int c = 0; c < 36; ++c) lg[rr][c] = 0.f;
            const int bq_ = mbase >> 13;
            const f32x2* sh2q = (const f32x2*)(mod + (size_t)bq_ * MODW + 3 * DM) + lane; const f32x2* sc2q = (const f32x2*)(mod + (size_t)bq_ * MODW + 4 * DM) + lane;
            const f32x2* x1a = (const f32x2*)(V1 + (size_t)mbase * DM) + lane; const f32x2* x1b = x1a + DM / 2;
#pragma unroll 1
            for (int j = 0; j < 16; ++j) {
                __syncthreads();
                for (int idx = tid; idx < 128 * 9; idx += NWAVES * 64) { const int kk = idx / 9, q4 = idx % 9, k = 128 * j + kk;
                    const f32x4 w = (q4 < 8) ? *(const f32x4*)(w_router + (size_t)k * 32 + 4 * q4) : *(const f32x4*)(w_group + (size_t)k * 4);
                    *(LAS f32x4*)(wl + ((kk >> 1) + 64 * (kk & 1)) * 36 + 4 * q4) = w; }
                const f32x2 xa = x1a[64 * j], xb = x1b[64 * j], sh = sh2q[64 * j], sc = sc2q[64 * j] + 1.0f;
                const f32x2 ha2 = (xa - mean2[0]) * rstd2[0] * sc + sh, hb2 = (xb - mean2[1]) * rstd2[1] * sc + sh;
                __syncthreads();
#pragma unroll
                for (int e = 0; e < 2; ++e) {
                    const LAS f32x4* wr4 = (const LAS f32x4*)(wl + (lane + 64 * e) * 36);
                    const float ha = e ? ha2.y : ha2.x, hb1 = e ? hb2.y : hb2.x;
#pragma unroll
                    for (int q4 = 0; q4 < 9; ++q4) { const f32x4 w = wr4[q4];
#pragma unroll
                        for (int i = 0; i < 4; ++i) { lg[0][4 * q4 + i] += ha * w[i]; lg[1][4 * q4 + i] += hb1 * w[i]; } }
                }
            }
#pragma unroll
            for (int rr = 0; rr < 2; ++rr)
#pragma unroll
                for (int c = 0; c < 36; ++c) lg[rr][c] = wave_sum(lg[rr][c]);
            if (lane < 2) {
                const int m = mbase + lane;
                float l[36];
#pragma unroll
                for (int c = 0; c < 36; ++c) l[c] = (lane == 0 ? lg[0][c] : lg[1][c]) + (c < 32 ? b_router[c] : b_group[c - 32]);
                int gs = 0; float gm = l[32];
#pragma unroll
                for (int q = 1; q < 4; ++q) if (l[32 + q] > gm) { gm = l[32 + q]; gs = q; }
                float den = 0.f;
#pragma unroll
                for (int q = 0; q < 4; ++q) den += __expf(l[32 + q] - gm);
                const float pg = 1.0f / den;
                int i0 = 0, i1 = 1; float v0 = 0.f, v1 = 0.f;
#pragma unroll
                for (int q = 0; q < 4; ++q) {
                    int a0 = 0; float b0 = l[8 * q];
#pragma unroll
                    for (int j = 1; j < 8; ++j) if (l[8 * q + j] > b0) { b0 = l[8 * q + j]; a0 = j; }
                    int a1 = -1; float b1 = -3.0e38f;
#pragma unroll
                    for (int j = 0; j < 8; ++j) if (j != a0 && l[8 * q + j] > b1) { b1 = l[8 * q + j]; a1 = j; }
                    if (q == gs) { i0 = a0; i1 = a1; v0 = b0; v1 = b1; }
                }
                const float e1 = __expf(v1 - v0), w0 = pg / (1.0f + e1), w1 = pg * e1 / (1.0f + e1);
                const int x0 = gs * 8 + i0, x1 = gs * 8 + i1;
                const int p0 = (int)atomicAdd(ctl + CW_CNT + x0, 1u), p1 = (int)atomicAdd(ctl + CW_CNT + x1, 1u);
                toklist[x0 * ECAP + p0] = m; toklist[x1 * ECAP + p1] = m;
                int* ag = asg + (size_t)m * 8;
                ag[0] = x0; ag[1] = p0; ag[2] = __float_as_int(w0); ag[3] = 0; ag[4] = x1; ag[5] = p1; ag[6] = __float_as_int(w1); ag[7] = 0;
            }
        }
        __syncthreads();
        if (BOTH(6)) GRID_BAR();
    }

    LAS int* tp = (LAS int*)(lds + LDSCTL_OFF);
#define BUILD_TP() do { __syncthreads(); if (tid == 0) { int acc_ = 0; for (int e_ = 0; e_ < NE; ++e_) { const int c_ = (int)__hip_atomic_load(ctl + CW_CNT + e_, RLX_AGENT); tp[e_] = acc_; tp[40 + e_] = c_; acc_ += (c_ + 255) >> 8; } tp[32] = acc_; } __syncthreads(); } while (0)

    if (IN(7)) {
        BUILD_TP();
        pg8::Gemm g{Hb, Wgu, DM}; pg8::MoeOrder<true, 2> S{tp, toklist, G, bx, tp[32] * 4};
        pg8::EpiGU E{HBb};
        pg8::gemm_phase<pg8::EpiGU, pg8::MoeOrder<true, 2>, true>(lds, g, S, E);
        if (BOTH(7)) GRID_BAR();
    }

    if (IN(8)) {
        BUILD_TP();
        pg8::Gemm g{HBb, Wd, DE}; pg8::MoeOrder<false, 3> S{tp, toklist, G, bx, tp[32] * 8};
        pg8::EpiDown E{YS};
        pg8::gemm_phase<pg8::EpiDown, pg8::MoeOrder<false, 3>, true>(lds, g, S, E);
        if (BOTH(8)) GRID_BAR();
    }

    if (IN(9)) {
        BUILD_TP();
        for (int m = gw; m < M; m += NGW) {
            const int b = m >> 13;
            const int* ag = asg + (size_t)m * 8;
            const int e0 = ag[0], p0 = ag[1], e1 = ag[4], p1 = ag[5]; const float w0 = __int_as_float(ag[2]), w1 = __int_as_float(ag[6]);
            const size_t r0 = (size_t)tp[e0] * 256 + p0, r1 = (size_t)tp[e1] * 256 + p1;
            const f32x4* xr = (const f32x4*)(V1 + (size_t)m * DM) + lane;
            const u32x2* y0 = (const u32x2*)(YS + r0 * DM) + lane; const u32x2* y1 = (const u32x2*)(YS + r1 * DM) + lane;
            const f32x4* g2 = (const f32x4*)(mod + (size_t)b * MODW + 5 * DM) + lane;
            f32x4 v[8]; float s = 0.f;
#pragma unroll
            for (int j = 0; j < 8; ++j) { const f32x4 xv = xr[64 * j], gq = g2[64 * j]; const u32x2 a = y0[64 * j], c = y1[64 * j];
                const f32x4 ya = {bflo(a.x), bfhi(a.x), bflo(a.y), bfhi(a.y)}, yc = {bflo(c.x), bfhi(c.x), bflo(c.y), bfhi(c.y)};
                v[j] = xv * ALPHA + gq * (ya * w0 + yc * w1); s += (v[j].x + v[j].y) + (v[j].z + v[j].w); }
            const float mean = wave_sum(s) * (1.0f / DM); float s2 = 0.f;
#pragma unroll
            for (int j = 0; j < 8; ++j) { v[j] = v[j] - mean; s2 += (v[j].x * v[j].x + v[j].y * v[j].y) + (v[j].z * v[j].z + v[j].w * v[j].w); }
            const float rstd = 1.0f / sqrtf(wave_sum(s2) * (1.0f / DM) + LN_EPS);
            f32x4* orow = (f32x4*)(args.out + (size_t)m * DM) + lane;
#pragma unroll
            for (int j = 0; j < 8; ++j) { const f32x4 gq = *((const f32x4*)ln2g + 64 * j + lane), bq = *((const f32x4*)ln2b + 64 * j + lane); orow[64 * j] = v[j] * rstd * gq + bq; }
        }
    }
#undef IN
#undef BOTH
}

extern "C" void kernel_launch(void* const* d_in, const int* in_sizes, int n_in, void* d_out, int out_size, void* d_ws, size_t ws_size, hipStream_t stream) {
    static int grid = 0;
    if (grid == 0) {
        if (n_in != 23 || in_sizes[0] != M * DM || out_size != M * DM || ws_size < WS_END) {
            fprintf(stderr, "kernel_launch: unexpected shapes (n_in %d, in0 %d, out %d, ws %zu); nothing launched\n", n_in, n_in > 0 ? in_sizes[0] : -1, out_size, ws_size); grid = -1; return; }
        int dev = 0, cus = 0, per_cu = 0;
        if (hipGetDevice(&dev) != hipSuccess || hipDeviceGetAttribute(&cus, hipDeviceAttributeMultiprocessorCount, dev) != hipSuccess) { fprintf(stderr, "kernel_launch: device query failed\n"); grid = -1; return; }
        if (hipFuncSetAttribute((const void*)mk_fwd, hipFuncAttributeMaxDynamicSharedMemorySize, LDS_BYTES) != hipSuccess) { fprintf(stderr, "kernel_launch: hipFuncSetAttribute failed\n"); grid = -1; return; }
        if (hipOccupancyMaxActiveBlocksPerMultiprocessor(&per_cu, (const void*)mk_fwd, NWAVES * 64, LDS_BYTES) != hipSuccess || per_cu < 1)
            fprintf(stderr, "kernel_launch: note: occupancy query reports %d workgroups per CU\n", per_cu);
        (void)hipGetLastError();
        grid = cus;
    }
    if (grid < 0) return;
    if (hipMemsetAsync((char*)d_ws + WS_CTL, 0, CTL_ZERO_BYTES, stream) != hipSuccess) { fprintf(stderr, "kernel_launch: memset failed\n"); return; }
    Args a{};
    for (int i = 0; i < 23; ++i) a.in[i] = (const float*)d_in[i];
    a.out = (float*)d_out; a.ws = (unsigned char*)d_ws;
#if MK_PER_PHASE
    for (int p = 0; p < NPHASE; ++p) { a.ph_lo = p; a.ph_hi = p + 1; hipLaunchKernelGGL(mk_fwd, dim3(grid), dim3(NWAVES * 64), LDS_BYTES, stream, a); }
#else
    a.ph_lo = 0; a.ph_hi = NPHASE;
    hipLaunchKernelGGL(mk_fwd, dim3(grid), dim3(NWAVES * 64), LDS_BYTES, stream, a);
#endif
    const hipError_t le = hipPeekAtLastError();
    if (le != hipSuccess) fprintf(stderr, "kernel_launch: launch failed: %s\n", hipGetErrorName(le));
}
```

```cpp
#include <hip/hip_runtime.h>
#include <cstdio>
#include <cstdint>

#ifndef MK_PER_PHASE
#define MK_PER_PHASE 0
#endif

#define GAS __attribute__((address_space(1)))
#define LAS __attribute__((address_space(3)))
typedef unsigned short bf16_t;
typedef short bf16x8 __attribute__((ext_vector_type(8)));
typedef short s16x4 __attribute__((ext_vector_type(4)));
typedef float f32x2 __attribute__((ext_vector_type(2)));
typedef float f32x4 __attribute__((ext_vector_type(4)));
typedef float f32x16 __attribute__((ext_vector_type(16)));
typedef unsigned u32x2 __attribute__((ext_vector_type(2)));
typedef unsigned u32x4 __attribute__((ext_vector_type(4)));
typedef __bf16 bf16x2_t __attribute__((ext_vector_type(2)));

constexpr int BATCH = 2, SEQ = 8192, DM = 2048, M = BATCH * SEQ;
constexpr int NHEAD = 8, HD = 128, SBW = 1024, SGW = 1024;
constexpr int INC = 9216, N1 = 7168;
constexpr int NE = 32, DE = 512, ECAP = 16384;
constexpr int MODW = 6 * DM;
constexpr float LN_EPS = 1e-5f;
constexpr float ALPHA = 1.189207115002721f;
constexpr float QSCALE = 0.08838834764831845f * 1.4426950408889634f;
constexpr int HBROWS = 40960;

constexpr size_t MiB = 1u << 20;
constexpr size_t WS_CTL = 0, CTL_ZERO_BYTES = 1 * MiB;
constexpr size_t WS_MODP = 1 * MiB;
constexpr size_t WS_MOD = 2 * MiB;
constexpr size_t WS_TOK = 3 * MiB;
constexpr size_t WS_ASG = 5 * MiB;
constexpr size_t WS_WAB = 6 * MiB;
constexpr size_t WS_WOUT = 14 * MiB;
constexpr size_t WS_WGU = 22 * MiB;
constexpr size_t WS_WD = 150 * MiB;
constexpr size_t WS_WIN = 214 * MiB;
constexpr size_t WS_H = 250 * MiB;
constexpr size_t WS_Q = 314 * MiB, WS_K = 346 * MiB, WS_SU = 378 * MiB, WS_VT = 410 * MiB;
constexpr size_t WS_MRG = 314 * MiB;
constexpr size_t WS_YS = 314 * MiB;
constexpr size_t WS_SA = 474 * MiB, WS_SB = 538 * MiB;
constexpr size_t WS_V1 = 474 * MiB;
constexpr size_t WS_OAB = 602 * MiB;
constexpr size_t WS_HB = 602 * MiB;
constexpr size_t WS_END = 666 * MiB;
constexpr int CW_CNT = 64;
constexpr int CW_BAR = 4096;

constexpr int RING_BYTES = 131072;
constexpr int LDSCTL_OFF = RING_BYTES, MISC_OFF = LDSCTL_OFF + 320;
constexpr int LDS_BYTES = 147456;
constexpr int NWAVES = 8;

#define RLX_AGENT __ATOMIC_RELAXED, __HIP_MEMORY_SCOPE_AGENT
#define LDS_WAIT() asm volatile("s_waitcnt lgkmcnt(0)" ::: "memory")
__device__ __forceinline__ unsigned f2bf(float f) { unsigned u = __builtin_bit_cast(unsigned, f); return (u + 0x7fffu + ((u >> 16) & 1u)) >> 16; }
__device__ __forceinline__ unsigned pk2(float lo, float hi) { f32x2 v = {lo, hi}; bf16x2_t b = __builtin_convertvector(v, bf16x2_t); return __builtin_bit_cast(unsigned, b); }
__device__ __forceinline__ float bflo(unsigned u) { return __uint_as_float(u << 16); }
__device__ __forceinline__ float bfhi(unsigned u) { return __uint_as_float(u & 0xffff0000u); }
__device__ __forceinline__ float wave_sum(float v) {
#pragma unroll
    for (int o = 1; o < 64; o <<= 1) v += __shfl_xor(v, o);
    return v;
}
__device__ __forceinline__ float sigmoidf_(float x) { return __builtin_amdgcn_rcpf(1.0f + __builtin_amdgcn_exp2f(-1.4426950408889634f * x)); }
__device__ __forceinline__ f32x2 gelu_pk(f32x2 v) {
    const f32x2 av = __builtin_elementwise_abs(v), d = av * 0.2316418882f + 1.0f;
    f32x2 t; t.x = __builtin_amdgcn_rcpf(d.x); t.y = __builtin_amdgcn_rcpf(d.y);
    f32x2 q = t * 0.5307027145f + (-0.7265760135f); q = q * t + 0.7107068705f; q = q * t + (-0.142248368f); q = q * t + 0.127414796f; q = q * t;
    const f32x2 s = (v * v) * (-0.72134752044f);
    f32x2 e; e.x = __builtin_amdgcn_exp2f(s.x); e.y = __builtin_amdgcn_exp2f(s.y);
    const f32x2 m = v * (q * e), r = v - m;
    f32x2 o; o.x = v.x < 0.f ? m.x : r.x; o.y = v.y < 0.f ? m.y : r.y; return o;
}
__device__ __forceinline__ int xcd_remap(int L, int nwg) { const int q = nwg / 8, r = nwg % 8, xcd = L % 8, off = L / 8; return (xcd < r ? xcd * (q + 1) : r * (q + 1) + (xcd - r) * q) + off; }

namespace pg8 {
constexpr int BM = 256, BK = 64, HALF = 128, HTB = HALF * BK * 2, STAGE_BYTES = 8 * HTB, NXCD = 8, WGM = 8;
__host__ __device__ __forceinline__ int lds_byte(int r, int c) { const int st = (r >> 4) * 2 + (c >> 5), rr = r & 15, cc = c & 31, ob = rr * 64 + cc * 2; return st * 1024 + (ob ^ (((ob >> 9) & 1) << 5)); }
__host__ __device__ __forceinline__ void stage_rc(int b, int& R, int& C) { const int st = b / 1024, sb = b % 1024, swz = sb ^ (((sb >> 9) & 1) << 5); R = (st >> 1) * 16 + swz / 64; C = (st & 1) * 32 + (swz % 64) / 2; }
__host__ __device__ __forceinline__ int perm32(int rho) { const int n = rho >> 4, i = rho & 15; return 8 * (i >> 2) + 4 * n + (i & 3); }

struct Unit { int pm, pn, ax, ax2; };
struct Gemm { const bf16_t* A; const bf16_t* Bt; int K; };

struct StaticOrder {
    static constexpr bool GATHER = false;
    int nM, nN, nwg, G, c;
    __device__ void init(int Mr, int Nr, int G_, int c_) { nM = Mr / BM; nN = Nr / BM; nwg = nM * nN; G = G_; c = c_; }
    __device__ bool next(int i, Unit& u) const {
        const long L = (long)i * G + c; if (L >= nwg) return false;
        const int wgid = xcd_remap((int)L, nwg);
        const int nig = WGM * nN, gid = wgid / nig, fm = gid * WGM, gsz = (nM - fm) < WGM ? (nM - fm) : WGM;
        u.pm = fm + ((wgid % nig) % gsz); u.pn = (wgid % nig) / gsz; u.ax = 0; u.ax2 = 0; return true;
    }
    __device__ __forceinline__ int row_src(const Unit&, int) const { return 0; }
};
struct PairOrder {
    static constexpr bool GATHER = false;
    StaticOrder so;
    __device__ bool next(int i, Unit& u) const { Unit t; if (!so.next(i >> 1, t)) return false; const int hf = i & 1; u.pm = t.pm + 64 * hf; u.pn = t.pn + 8 * hf; u.ax = hf; u.ax2 = 0; return true; }
    __device__ __forceinline__ int row_src(const Unit&, int) const { return 0; }
};
template <bool G_, int SH> struct MoeOrder {
    static constexpr bool GATHER = G_;
    const LAS int* tp;
    const int* tok;
    int G, c, total;
    __device__ bool next(int i, Unit& u) const {
        const long L = (long)i * G + c; if (L >= total) return false;
        const int wgid = xcd_remap((int)L, total);
        const int tile = wgid >> SH, pn = wgid & ((1 << SH) - 1);
        int e = 0;
#pragma unroll 8
        for (int j = 1; j < NE; ++j) e += (tp[j] <= tile) ? 1 : 0;
        const int mt = tile - tp[e]; int valid = tp[40 + e] - mt * 256; valid = valid > 256 ? 256 : valid;
        u.pm = tile; u.pn = (e << SH) + pn; u.ax = e * ECAP + mt * 256; u.ax2 = valid; return true;
    }
    __device__ __forceinline__ int row_src(const Unit& u, int r) const { return r < u.ax2 ? tok[u.ax + r] : 0; }
};

__device__ __forceinline__ unsigned cvt_pk_bf16(float lo, float hi) { return pk2(lo, hi); }

#define PG8_ACC f32x4 (&acc)[2][2][4][2]

struct EpiG1 {
    static constexpr bool PERM = true, KEEP = false;
    bf16_t *q, *k, *su, *sa, *sb;
    __device__ __forceinline__ bool keep(const Unit&) const { return false; }
    __device__ __forceinline__ void operator()(PG8_ACC, const Unit& u, int wr, int wc, int fr, int fq) const {
        bf16_t* base; int ldc, ct, mode;
        if (u.pn < 4) { base = q; ldc = 1024; ct = u.pn; mode = 0; }
        else if (u.pn < 8) { base = k; ldc = 1024; ct = u.pn - 4; mode = 1; }
        else if (u.pn < 12) { base = su; ldc = 1024; ct = u.pn - 8; mode = 2; }
        else if (u.pn < 20) { base = sa; ldc = 2048; ct = u.pn - 12; mode = 3; }
        else { base = sb; ldc = 2048; ct = u.pn - 20; mode = 3; }
        const int row0 = u.pm * BM + wr * 64 + fr, col0 = ct * BM + wc * 32 + 8 * fq;
#pragma unroll
        for (int ai = 0; ai < 2; ++ai)
#pragma unroll
            for (int m = 0; m < 4; ++m) { bf16_t* rowp = base + (size_t)(row0 + ai * HALF + m * 16) * ldc + col0;
#pragma unroll
                for (int bj = 0; bj < 2; ++bj) { f32x4 v0 = acc[ai][bj][m][0], v1 = acc[ai][bj][m][1];
                    if (mode == 0) { v0 = v0 * QSCALE; v1 = v1 * QSCALE; }
                    else if (mode == 2) { f32x2 a = gelu_pk((f32x2){v0[0], v0[1]}), b = gelu_pk((f32x2){v0[2], v0[3]}), c = gelu_pk((f32x2){v1[0], v1[1]}), d = gelu_pk((f32x2){v1[2], v1[3]});
                        v0 = (f32x4){a.x, a.y, b.x, b.y}; v1 = (f32x4){c.x, c.y, d.x, d.y}; }
                    else if (mode == 3) {
#pragma unroll
                        for (int j = 0; j < 4; ++j) { v0[j] = sigmoidf_(v0[j]); v1[j] = sigmoidf_(v1[j]); } }
                    u32x4 w; w.x = cvt_pk_bf16(v0[0], v0[1]); w.y = cvt_pk_bf16(v0[2], v0[3]); w.z = cvt_pk_bf16(v1[0], v1[1]); w.w = cvt_pk_bf16(v1[2], v1[3]);
                    *(u32x4*)(rowp + bj * HALF) = w; } }
    }
};
struct EpiG2 {
    static constexpr bool PERM = true, KEEP = false;
    bf16_t* vt;
    __device__ __forceinline__ bool keep(const Unit&) const { return false; }
    __device__ __forceinline__ void operator()(PG8_ACC, const Unit& u, int wr, int wc, int fr, int fq) const {
        const int row0 = u.pm * BM + wr * 64 + fr, col0 = u.pn * BM + wc * 32 + 8 * fq; const bool gl = u.pm >= 4;
#pragma unroll
        for (int ai = 0; ai < 2; ++ai)
#pragma unroll
            for (int m = 0; m < 4; ++m) { bf16_t* rowp = vt + (size_t)(row0 + ai * HALF + m * 16) * M + col0;
#pragma unroll
                for (int bj = 0; bj < 2; ++bj) { f32x4 v0 = acc[ai][bj][m][0], v1 = acc[ai][bj][m][1];
                    if (gl) { f32x2 a = gelu_pk((f32x2){v0[0], v0[1]}), b = gelu_pk((f32x2){v0[2], v0[3]}), c = gelu_pk((f32x2){v1[0], v1[1]}), d = gelu_pk((f32x2){v1[2], v1[3]});
                        v0 = (f32x4){a.x, a.y, b.x, b.y}; v1 = (f32x4){c.x, c.y, d.x, d.y}; }
                    u32x4 w; w.x = cvt_pk_bf16(v0[0], v0[1]); w.y = cvt_pk_bf16(v0[2], v0[3]); w.z = cvt_pk_bf16(v1[0], v1[1]); w.w = cvt_pk_bf16(v1[2], v1[3]);
                    *(u32x4*)(rowp + bj * HALF) = w; } }
    }
};
struct EpiGate {
    static constexpr bool PERM = true, KEEP = true;
    const bf16_t *sa, *sb; bf16_t* O;
    __device__ __forceinline__ bool keep(const Unit& u) const { return u.ax == 0; }
    __device__ __forceinline__ void operator()(PG8_ACC, const Unit& u, int wr, int wc, int fr, int fq) const {
        const int pm = u.ax ? u.pm - 64 : u.pm, pn = u.ax ? u.pn - 8 : u.pn;
        const int row0 = pm * BM + wr * 64 + fr, col0 = pn * BM + wc * 32 + 8 * fq;
#pragma unroll
        for (int ai = 0; ai < 2; ++ai)
#pragma unroll
            for (int m = 0; m < 4; ++m) { const size_t off = (size_t)(row0 + ai * HALF + m * 16) * DM + col0;
#pragma unroll
                for (int bj = 0; bj < 2; ++bj) {
                    const u32x4 b4 = *(const u32x4*)(sb + off + bj * HALF);
                    float s[8] = {bflo(b4.x), bfhi(b4.x), bflo(b4.y), bfhi(b4.y), bflo(b4.z), bfhi(b4.z), bflo(b4.w), bfhi(b4.w)};
#pragma unroll
                    for (int j = 0; j < 8; ++j) s[j] = fmaxf(s[j], 1e-30f);
                    if (u.ax == 0) {
                        const u32x4 a4 = *(const u32x4*)(sa + off + bj * HALF);
                        const float a[8] = {bflo(a4.x), bfhi(a4.x), bflo(a4.y), bfhi(a4.y), bflo(a4.z), bfhi(a4.z), bflo(a4.w), bfhi(a4.w)};
#pragma unroll
                        for (int j = 0; j < 4; ++j) { acc[ai][bj][m][0][j] *= a[j] * __builtin_amdgcn_rcpf(s[j]); acc[ai][bj][m][1][j] *= a[4 + j] * __builtin_amdgcn_rcpf(s[4 + j]); }
                    } else {
                        f32x4 v0 = acc[ai][bj][m][0], v1 = acc[ai][bj][m][1];
#pragma unroll
                        for (int j = 0; j < 4; ++j) { v0[j] *= s[j]; v1[j] *= s[4 + j]; }
                        u32x4 w; w.x = cvt_pk_bf16(v0[0], v0[1]); w.y = cvt_pk_bf16(v0[2], v0[3]); w.z = cvt_pk_bf16(v1[0], v1[1]); w.w = cvt_pk_bf16(v1[2], v1[3]);
                        *(u32x4*)(O + off + bj * HALF) = w;
                    } } }
    }
};
struct EpiV1 {
    static constexpr bool PERM = false, KEEP = false;
    const float* x; const float* mod; float* O;
    __device__ __forceinline__ bool keep(const Unit&) const { return false; }
    __device__ __forceinline__ void operator()(PG8_ACC, const Unit& u, int wr, int wc, int fr, int fq) const {
        const int row0 = u.pm * BM + wr * 64 + fr, col0 = u.pn * BM + wc * 32 + 4 * fq;
        const float* g1 = mod + (size_t)(u.pm >> 5) * MODW + 2 * DM;
        f32x4 gv[2][2];
#pragma unroll
        for (int bj = 0; bj < 2; ++bj)
#pragma unroll
            for (int n = 0; n < 2; ++n) gv[bj][n] = *(const f32x4*)(g1 + col0 + bj * HALF + n * 16);
#pragma unroll
        for (int ai = 0; ai < 2; ++ai)
#pragma unroll
            for (int m = 0; m < 4; ++m) { const size_t off = (size_t)(row0 + ai * HALF + m * 16) * DM + col0;
#pragma unroll
                for (int bj = 0; bj < 2; ++bj)
#pragma unroll
                    for (int n = 0; n < 2; ++n) { const f32x4 xv = *(const f32x4*)(x + off + bj * HALF + n * 16);
                        *(f32x4*)(O + off + bj * HALF + n * 16) = xv * ALPHA + gv[bj][n] * acc[ai][bj][m][n]; } }
    }
};
struct EpiGU {
    static constexpr bool PERM = true, KEEP = false;
    bf16_t* hb;
    __device__ __forceinline__ bool keep(const Unit&) const { return false; }
    __device__ __forceinline__ void operator()(PG8_ACC, const Unit& u, int wr, int wc, int fr, int fq) const {
        const int row0 = u.pm * BM + wr * 64 + fr, col0 = (u.pn & 3) * HALF + wc * 32 + 8 * fq;
#pragma unroll
        for (int ai = 0; ai < 2; ++ai)
#pragma unroll
            for (int m = 0; m < 4; ++m) { bf16_t* rowp = hb + (size_t)(row0 + ai * HALF + m * 16) * DE + col0;
                f32x4 g0 = acc[ai][0][m][0], g1 = acc[ai][0][m][1]; const f32x4 u0 = acc[ai][1][m][0], u1 = acc[ai][1][m][1];
#pragma unroll
                for (int j = 0; j < 4; ++j) { g0[j] = g0[j] * sigmoidf_(g0[j]) * u0[j]; g1[j] = g1[j] * sigmoidf_(g1[j]) * u1[j]; }
                u32x4 w; w.x = cvt_pk_bf16(g0[0], g0[1]); w.y = cvt_pk_bf16(g0[2], g0[3]); w.z = cvt_pk_bf16(g1[0], g1[1]); w.w = cvt_pk_bf16(g1[2], g1[3]);
                *(u32x4*)rowp = w; }
    }
};
struct EpiDown {
    static constexpr bool PERM = true, KEEP = false;
    bf16_t* ys;
    __device__ __forceinline__ bool keep(const Unit&) const { return false; }
    __device__ __forceinline__ void operator()(PG8_ACC, const Unit& u, int wr, int wc, int fr, int fq) const {
        const int row0 = u.pm * BM + wr * 64 + fr, col0 = (u.pn & 7) * BM + wc * 32 + 8 * fq;
#pragma unroll
        for (int ai = 0; ai < 2; ++ai)
#pragma unroll
            for (int m = 0; m < 4; ++m) { bf16_t* rowp = ys + (size_t)(row0 + ai * HALF + m * 16) * DM + col0;
#pragma unroll
                for (int bj = 0; bj < 2; ++bj) { const f32x4 v0 = acc[ai][bj][m][0], v1 = acc[ai][bj][m][1];
                    u32x4 w; w.x = cvt_pk_bf16(v0[0], v0[1]); w.y = cvt_pk_bf16(v0[2], v0[3]); w.z = cvt_pk_bf16(v1[0], v1[1]); w.w = cvt_pk_bf16(v1[2], v1[3]);
                    *(u32x4*)(rowp + bj * HALF) = w; } }
    }
};

template <class Epi, class Sched, bool ALIGN_EPI>
__device__ __forceinline__ void gemm_phase(LAS unsigned char* lds, const Gemm g, const Sched& S, const Epi& E) {
    const int tid = threadIdx.x, wid = __builtin_amdgcn_readfirstlane(tid >> 6), lane = tid & 63, wr = wid >> 2, wc = wid & 3, fr = lane & 15, fq = lane >> 4;
    const int K = g.K, nt = K / BK;
    unsigned voffA[2], voffB[2]; int stR[2], stC[2];
#pragma unroll
    for (int i = 0; i < 2; ++i) { int R, C; stage_rc(tid * 16 + i * 8192, R, C); const int Rb = Epi::PERM ? ((R & ~31) + perm32(R & 31)) : R;
        stR[i] = R; stC[i] = C; voffA[i] = (unsigned)(R * K + C) * 2u; voffB[i] = (unsigned)(Rb * K + C) * 2u; }
    const size_t kstep = (size_t)(BK * 2);
    const size_t hstep = (size_t)HALF * K * 2;
    const size_t tstep = 2 * hstep;
    const unsigned ldsw = (unsigned)wid * 1024u;
    const int aoff = lds_byte(wr * 64 + fr, fq * 8), boff = lds_byte(wc * 32 + fr, fq * 8);
#define PG8_SA(b, h) (((b) * 2 + (h)) * HTB)
#define PG8_SB(b, h) ((4 + (b) * 2 + (h)) * HTB)
#define PG8_STAGE(bufoff, gbase, voff) do { _Pragma("unroll") for (int _i = 0; _i < 2; ++_i) \
        __builtin_amdgcn_global_load_lds((const unsigned*)((const char*)(gbase) + (voff)[_i]), (LAS unsigned*)(lds + (bufoff) + ldsw + _i * 8192), 16, 0, 0); } while (0)
#define PG8_STAGE_A(bufoff, ubase, vg, h, kb) do { if constexpr (Sched::GATHER) PG8_STAGE(bufoff, (const char*)g.A + (kb), (vg)[h]); else PG8_STAGE(bufoff, (ubase) + (h) * hstep + (kb), voffA); } while (0)
#define PG8_LDA(dst, b, h) do { _Pragma("unroll") for (int m = 0; m < 4; ++m) _Pragma("unroll") for (int k = 0; k < 2; ++k) dst[m][k] = *(const LAS bf16x8*)(lds + PG8_SA(b, h) + aoff + m * 2048 + k * 1024); } while (0)
#define PG8_LDB(dst, b, h) do { _Pragma("unroll") for (int n = 0; n < 2; ++n) _Pragma("unroll") for (int k = 0; k < 2; ++k) dst[n][k] = *(const LAS bf16x8*)(lds + PG8_SB(b, h) + boff + n * 2048 + k * 1024); } while (0)
#define PG8_MMA(ai, bj, At, Bt) do { __builtin_amdgcn_s_setprio(1); _Pragma("unroll") for (int m = 0; m < 4; ++m) _Pragma("unroll") for (int n = 0; n < 2; ++n) _Pragma("unroll") for (int k = 0; k < 2; ++k) \
        acc[ai][bj][m][n] = __builtin_amdgcn_mfma_f32_16x16x32_bf16(Bt[n][k], At[m][k], acc[ai][bj][m][n], 0, 0, 0); __builtin_amdgcn_s_setprio(0); } while (0)
#define PG8_WAIT_V(n) asm volatile("s_waitcnt vmcnt(" #n ")" ::: "memory")
#define PG8_WAIT_L(n) asm volatile("s_waitcnt lgkmcnt(" #n ")" ::: "memory")
#define PG8_BAR __builtin_amdgcn_s_barrier()
#define PG8_SCHED __builtin_amdgcn_sched_barrier(0)
#define PG8_UNI(u) do { (u).pm = __builtin_amdgcn_readfirstlane((u).pm); (u).pn = __builtin_amdgcn_readfirstlane((u).pn); (u).ax = __builtin_amdgcn_readfirstlane((u).ax); (u).ax2 = __builtin_amdgcn_readfirstlane((u).ax2); } while (0)
#define PG8_FILL(v, u) do { _Pragma("unroll") for (int _h = 0; _h < 2; ++_h) _Pragma("unroll") for (int _i = 0; _i < 2; ++_i) \
        (v)[_h][_i] = (unsigned)(S.row_src((u), _h * HALF + stR[_i]) * K + stC[_i]) * 2u; } while (0)
    Unit cur, nxt; int ui = 0;
    if (!S.next(0, cur)) return;
    PG8_UNI(cur);
    f32x4 acc[2][2][4][2];
#pragma unroll
    for (int a = 0; a < 2; ++a)
#pragma unroll
        for (int b = 0; b < 2; ++b)
#pragma unroll
            for (int m = 0; m < 4; ++m)
#pragma unroll
                for (int n = 0; n < 2; ++n) acc[a][b][m][n] = (f32x4){0.f, 0.f, 0.f, 0.f};
    bf16x8 At[4][2], B0[2][2], B1[2][2];
    unsigned vAc[2][2] = {{0u, 0u}, {0u, 0u}}, vAn[2][2] = {{0u, 0u}, {0u, 0u}}, vA2[2][2] = {{0u, 0u}, {0u, 0u}};
    if constexpr (Sched::GATHER) PG8_FILL(vAc, cur);
    const char* cA = (const char*)g.A + (Sched::GATHER ? (size_t)0 : (size_t)cur.pm * tstep); const char* cB = (const char*)g.Bt + (size_t)cur.pn * tstep;
    PG8_STAGE(PG8_SB(0, 0), cB, voffB); PG8_STAGE(PG8_SB(0, 1), cB + hstep, voffB); PG8_STAGE_A(PG8_SA(0, 0), cA, vAc, 0, (size_t)0); PG8_STAGE_A(PG8_SA(0, 1), cA, vAc, 1, (size_t)0);
    if (wr == 1) PG8_BAR;
    PG8_WAIT_V(2); PG8_BAR;
    PG8_STAGE(PG8_SB(1, 0), cB + kstep, voffB); PG8_STAGE_A(PG8_SA(1, 0), cA, vAc, 0, kstep); PG8_STAGE(PG8_SB(1, 1), cB + hstep + kstep, voffB);
    PG8_WAIT_V(6); PG8_BAR;
    for (;;) {
        bool has_next = S.next(ui + 1, nxt);
        has_next = __builtin_amdgcn_readfirstlane((int)has_next) != 0;
        if (has_next) { PG8_UNI(nxt); if constexpr (Sched::GATHER) PG8_FILL(vAn, nxt); }
        const char* nA = (has_next && !Sched::GATHER) ? (const char*)g.A + (size_t)nxt.pm * tstep : cA; const char* nB = has_next ? (const char*)g.Bt + (size_t)nxt.pn * tstep : cB;
        for (int t = 0; t < nt; t += 2) {
            const bool last = (t == nt - 2);
            const size_t k1 = (size_t)(t + 1) * kstep;
            const size_t k2 = last ? (size_t)0 : (size_t)(t + 2) * kstep, k3 = k2 + kstep;
            const char* a2 = last ? nA : cA; const char* b2 = (last ? nB : cB) + k2; const char* b3 = b2 + kstep;
            if constexpr (Sched::GATHER) {
#pragma unroll
                for (int h = 0; h < 2; ++h)
#pragma unroll
                    for (int i = 0; i < 2; ++i) vA2[h][i] = (last && has_next) ? vAn[h][i] : vAc[h][i];
            }
            PG8_LDB(B0, 0, 0); PG8_LDB(B1, 0, 1); PG8_SCHED; PG8_LDA(At, 0, 0); PG8_STAGE_A(PG8_SA(1, 1), cA, vAc, 1, k1);
            PG8_WAIT_V(8); PG8_WAIT_L(0); PG8_BAR; PG8_MMA(0, 0, At, B0); PG8_MMA(0, 1, At, B1); PG8_BAR; PG8_SCHED;
            PG8_LDA(At, 0, 1); PG8_STAGE(PG8_SB(0, 0), b2, voffB); PG8_STAGE(PG8_SB(0, 1), b2 + hstep, voffB); PG8_STAGE_A(PG8_SA(0, 0), a2, vA2, 0, k2);
            PG8_WAIT_V(8); PG8_WAIT_L(0); PG8_BAR; PG8_MMA(1, 0, At, B0); PG8_MMA(1, 1, At, B1); PG8_BAR; PG8_SCHED;
            PG8_LDB(B0, 1, 0); PG8_LDB(B1, 1, 1); PG8_SCHED; PG8_LDA(At, 1, 0); PG8_STAGE_A(PG8_SA(0, 1), a2, vA2, 1, k2);
            PG8_WAIT_V(8); PG8_WAIT_L(0); PG8_BAR; PG8_MMA(0, 0, At, B0); PG8_MMA(0, 1, At, B1); PG8_BAR; PG8_SCHED;
            PG8_LDA(At, 1, 1); PG8_STAGE(PG8_SB(1, 0), b3, voffB); PG8_STAGE(PG8_SB(1, 1), b3 + hstep, voffB); PG8_STAGE_A(PG8_SA(1, 0), a2, vA2, 0, k3);
            PG8_WAIT_V(8); PG8_WAIT_L(0); PG8_BAR; PG8_MMA(1, 0, At, B0); PG8_MMA(1, 1, At, B1); PG8_BAR; PG8_SCHED;
        }
        if constexpr (ALIGN_EPI) { if (wr == 0) PG8_BAR; }
        E(acc, cur, wr, wc, fr, fq);
        if (!has_next) break;
        if (!(Epi::KEEP && E.keep(cur))) {
#pragma unroll
            for (int a = 0; a < 2; ++a)
#pragma unroll
                for (int b = 0; b < 2; ++b)
#pragma unroll
                    for (int m = 0; m < 4; ++m)
#pragma unroll
                        for (int n = 0; n < 2; ++n) acc[a][b][m][n] = (f32x4){0.f, 0.f, 0.f, 0.f};
        }
        cur = nxt; cA = nA; cB = nB; ++ui;
        if constexpr (Sched::GATHER) {
#pragma unroll
            for (int h = 0; h < 2; ++h)
#pragma unroll
                for (int i = 0; i < 2; ++i) vAc[h][i] = vAn[h][i];
        }
        if constexpr (ALIGN_EPI) { if (wr == 1) PG8_BAR; }
    }
    PG8_WAIT_V(0);
    if constexpr (!ALIGN_EPI) { if (wr == 0) PG8_BAR; }
    PG8_BAR;
#undef PG8_SA
#undef PG8_SB
#undef PG8_STAGE
#undef PG8_STAGE_A
#undef PG8_LDA
#undef PG8_LDB
#undef PG8_MMA
#undef PG8_WAIT_V
#undef PG8_WAIT_L
#undef PG8_BAR
#undef PG8_SCHED
#undef PG8_UNI
#undef PG8_FILL
}
}

#define XB_TMO      128
#define XB_XCNT(j)  (256  + 64 * (j))
#define XB_XSUB(j)  (1280 + 64 * (j))
#define XB_XGEN(j)  (2304 + 64 * (j))
#define XB_TOP      3328
#define XB_TOPGEN   3392
#define XCD_BAR_WORDS 3456
#define XB_SPIN_CAP (1u << 18)
__device__ __forceinline__ unsigned xb_ld(unsigned* p)              { return __hip_atomic_load(p, __ATOMIC_RELAXED, __HIP_MEMORY_SCOPE_AGENT); }
__device__ __forceinline__ unsigned xb_add(unsigned* p, unsigned v) { return __hip_atomic_fetch_add(p, v, __ATOMIC_RELAXED, __HIP_MEMORY_SCOPE_AGENT); }
__device__ __forceinline__ unsigned xb_xcc_id() { return (unsigned)__builtin_amdgcn_s_getreg((3 << 11) | 20) & 0xFu; }
#define XB_SPIN(cond, bar) do { unsigned _sp = 0; while (cond) { __builtin_amdgcn_s_sleep(1); \
    if ((++_sp & 255u) == 0u) { if (xb_ld(&(bar)[XB_TMO])) break; if (_sp > XB_SPIN_CAP) { atomicAdd(&(bar)[XB_TMO], 1u); break; } } } } while (0)
struct XcdBarrier { unsigned* bar; unsigned x; volatile LAS unsigned* st; };
__device__ __forceinline__ XcdBarrier xcd_barrier_post(unsigned* bar, volatile LAS unsigned* st) {
    XcdBarrier b; b.bar = bar; b.x = xb_xcc_id(); b.st = st;
    if (threadIdx.x == 0) (void)xb_add(&bar[XB_XCNT(b.x)], 1u);
    return b;
}
__device__ __forceinline__ void xcd_barrier_complete(unsigned* bar, unsigned x, unsigned& nloc, unsigned& nx) {
    const unsigned G = gridDim.x * gridDim.y * gridDim.z;
    unsigned sum, cnt, mine, sp = 0u;
    for (;;) {
        sum = 0u; cnt = 0u; mine = 0u;
#pragma unroll
        for (unsigned j = 0; j < 16; ++j) { const unsigned c = xb_ld(&bar[XB_XCNT(j)]); sum += c; cnt += (c > 0u) ? 1u : 0u; mine = (j == x) ? c : mine; }
        if (sum == G) break;
        __builtin_amdgcn_s_sleep(1);
        if ((++sp & 255u) == 0u) { if (xb_ld(&bar[XB_TMO])) break; if (sp > XB_SPIN_CAP) { atomicAdd(&bar[XB_TMO], 1u); break; } }
    }
    nloc = mine > 0u ? mine : 1u; nx = cnt > 0u ? cnt : 1u;
}
__device__ __forceinline__ void xcd_barrier(const XcdBarrier& b) {
    asm volatile("s_waitcnt vmcnt(0)" ::: "memory");
    __syncthreads();
    if (threadIdx.x == 0) {
        unsigned* bar = b.bar;
        __builtin_amdgcn_s_waitcnt(0);
        unsigned nloc = b.st[0], nx = b.st[1];
        if (nloc == 0u) { xcd_barrier_complete(bar, b.x, nloc, nx); b.st[0] = nloc; b.st[1] = nx; }
        const unsigned old = xb_add(&bar[XB_XSUB(b.x)], 1u);
        const unsigned gen = old / nloc;
        if (old + 1u == (gen + 1u) * nloc) {
            __builtin_amdgcn_fence(__ATOMIC_RELEASE, "agent");
            asm volatile("s_waitcnt vmcnt(0)" ::: "memory");
            const unsigned og = xb_add(&bar[XB_TOP], 1u);
            const unsigned tg = og / nx;
            if (og + 1u == (tg + 1u) * nx) xb_add(&bar[XB_TOPGEN], 1u);
            else XB_SPIN(xb_ld(&bar[XB_TOPGEN]) == tg, bar);
            __builtin_amdgcn_fence(__ATOMIC_ACQUIRE, "agent");
            xb_add(&bar[XB_XGEN(b.x)], 1u);
            asm volatile("s_waitcnt vmcnt(0)" ::: "memory");
        } else {
            XB_SPIN(xb_ld(&bar[XB_XGEN(b.x)]) == gen, bar);
            __builtin_amdgcn_fence(__ATOMIC_ACQUIRE, "agent");
            asm volatile("s_waitcnt vmcnt(0)" ::: "memory");
        }
    }
    __syncthreads();
}

__device__ __forceinline__ void transpose_item(const float* W, int K, int N, bf16_t* WT, int k0, int n0, int dst_off, LAS float* scr, int lane) {
#pragma unroll 8
    for (int i = 0; i < 32; ++i) { const int kk = 2 * i + (lane >> 5); scr[kk * 33 + (lane & 31)] = W[(size_t)(k0 + kk) * N + n0 + (lane & 31)]; }
    LDS_WAIT(); asm volatile("" ::: "memory");
    const int c = lane & 7;
#pragma unroll
    for (int j = 0; j < 4; ++j) { const int n = (lane >> 3) + 8 * j; const LAS float* s = scr + (8 * c) * 33 + n;
        u32x4 o; o.x = pk2(s[0 * 33], s[1 * 33]); o.y = pk2(s[2 * 33], s[3 * 33]); o.z = pk2(s[4 * 33], s[5 * 33]); o.w = pk2(s[6 * 33], s[7 * 33]);
        *(u32x4*)(WT + (size_t)(dst_off + n0 + n) * K + k0 + 8 * c) = o; }
    LDS_WAIT(); asm volatile("" ::: "memory");
}
__device__ __forceinline__ int win_dst(int n0) {
    if (n0 < 2048) return n0;
    if (n0 < 3072) return 7168 + (n0 - 2048);
    if (n0 < 4096) return 2048 + (n0 - 3072);
    if (n0 < 5120) return 8192 + (n0 - 4096);
    return 3072 + (n0 - 5120);
}

__device__ __forceinline__ int crow(int r, int hi) { return (r & 3) + 8 * (r >> 2) + 4 * hi; }
__device__ __forceinline__ void sb_attn_unit(int b, int h, int qb, const bf16_t* Q, const bf16_t* Kb, const bf16_t* VT, bf16_t* Oa, int lane) {
    const int r32 = lane & 31, hi = lane >> 5;
    const size_t tok0 = (size_t)b * SEQ;
    bf16x8 qf[8];
    { const bf16_t* qp = Q + (tok0 + (size_t)qb * 32 + r32) * SBW + h * HD + 8 * hi;
#pragma unroll
      for (int st = 0; st < 8; ++st) qf[st] = *(const bf16x8*)(qp + 16 * st); }
    f32x16 o[4];
#pragma unroll
    for (int d = 0; d < 4; ++d)
#pragma unroll
        for (int r = 0; r < 16; ++r) o[d][r] = 0.f;
    float carry = 0.f;
    for (int kb = qb; kb >= 0; --kb) {
        const size_t mk = tok0 + (size_t)kb * 32;
        bf16x8 kf[8];
        { const bf16_t* kp = Kb + (mk + r32) * SBW + h * HD + 8 * hi;
#pragma unroll
          for (int st = 0; st < 8; ++st) kf[st] = *(const bf16x8*)(kp + 16 * st); }
        s16x4 vlo[4][2], vhi[4][2];
        { const bf16_t* vp = VT + (size_t)(h * HD + r32) * M + mk + 4 * hi;
#pragma unroll
          for (int d = 0; d < 4; ++d)
#pragma unroll
              for (int s = 0; s < 2; ++s) { vlo[d][s] = *(const s16x4*)(vp + (size_t)(d * 32) * M + 16 * s); vhi[d][s] = *(const s16x4*)(vp + (size_t)(d * 32) * M + 16 * s + 8); } }
        f32x16 sc;
#pragma unroll
        for (int r = 0; r < 16; ++r) sc[r] = 0.f;
#pragma unroll
        for (int st = 0; st < 8; ++st) sc = __builtin_amdgcn_mfma_f32_32x32x16_bf16(kf[st], qf[st], sc, 0, 0, 0);
        const bool diag = (kb == qb);
        float L[16];
#pragma unroll
        for (int r = 0; r < 16; ++r) {
            const float z = sc[r];
            const float sp = fmaxf(z, 0.f) + __builtin_amdgcn_logf(1.0f + __builtin_amdgcn_exp2f(-fabsf(z)));
            const bool valid = !diag || (crow(r, hi) < r32);
            L[r] = valid ? -sp : 0.f;
        }
        float Gs[4], Gp[4], T[4];
#pragma unroll
        for (int g = 0; g < 4; ++g) { L[4 * g + 2] += L[4 * g + 3]; L[4 * g + 1] += L[4 * g + 2]; L[4 * g] += L[4 * g + 1]; Gs[g] = L[4 * g]; }
#pragma unroll
        for (int g = 0; g < 4; ++g) { Gp[g] = __shfl_xor(Gs[g], 32); T[g] = Gs[g] + Gp[g]; }
        float Aft[4]; Aft[3] = 0.f; Aft[2] = T[3]; Aft[1] = Aft[2] + T[2]; Aft[0] = Aft[1] + T[1];
        f32x16 p;
#pragma unroll
        for (int g = 0; g < 4; ++g) { const float add = Aft[g] + (hi == 0 ? Gp[g] : 0.f) + carry;
#pragma unroll
            for (int i = 0; i < 4; ++i) { const int r = 4 * g + i; const bool valid = !diag || (crow(r, hi) < r32);
                p[r] = valid ? __builtin_amdgcn_exp2f(sc[r] + L[r] + add) : 0.f; } }
        carry += Aft[0] + T[0];
#pragma unroll
        for (int s = 0; s < 2; ++s) {
            u32x4 pp; pp.x = pk2(p[8 * s], p[8 * s + 1]); pp.y = pk2(p[8 * s + 2], p[8 * s + 3]); pp.z = pk2(p[8 * s + 4], p[8 * s + 5]); pp.w = pk2(p[8 * s + 6], p[8 * s + 7]);
            const bf16x8 pf = __builtin_bit_cast(bf16x8, pp);
#pragma unroll
            for (int d = 0; d < 4; ++d) { const bf16x8 vf = __builtin_shufflevector(vlo[d][s], vhi[d][s], 0, 1, 2, 3, 4, 5, 6, 7);
                o[d] = __builtin_amdgcn_mfma_f32_32x32x16_bf16(pf, vf, o[d], 0, 0, 0); }
        }
        if (__builtin_amdgcn_ballot_w64(carry >= -64.0f) == 0ull) break;
    }
    bf16_t* op = Oa + (tok0 + (size_t)qb * 32) * SBW + h * HD + r32;
#pragma unroll
    for (int d = 0; d < 4; ++d)
#pragma unroll
        for (int r = 0; r < 16; ++r) op[(size_t)crow(r, hi) * SBW + d * 32] = (bf16_t)f2bf(o[d][r]);
}

__device__ __forceinline__ void sgu_item(int blk, int half, const bf16_t* SVT  , const bf16_t* SU, const float* sgu_w, const float* sgu_b,
                                         const float* lng, const float* lnb, bf16_t* Ob, LAS unsigned char* lds, int tid) {
    const int lane = tid & 63, wave = tid >> 6, r32 = lane & 31, hi = lane >> 5;
    const size_t m0 = (size_t)blk * 128;
    LAS float* part = (LAS float*)lds;
    LAS float* mu = part + 2048;
    LAS float* rs = mu + 128;
    LAS float* cw = rs + 128;
    { float sa = 0.f, qa = 0.f, sb = 0.f, qb = 0.f;
      const unsigned* src = (const unsigned*)(SVT + (size_t)wave * M + m0) + lane;
#pragma unroll 8
      for (int i = 0; i < 128; ++i) { const unsigned u = src[(size_t)i * 8 * (M / 2)]; const float x0 = bflo(u), x1 = bfhi(u); sa += x0; qa += x0 * x0; sb += x1; qb += x1 * x1; }
      part[(wave * 128 + 2 * lane) * 2 + 0] = sa; part[(wave * 128 + 2 * lane) * 2 + 1] = qa;
      part[(wave * 128 + 2 * lane + 1) * 2 + 0] = sb; part[(wave * 128 + 2 * lane + 1) * 2 + 1] = qb; }
    __syncthreads();
    if (tid < 128) { float s = 0.f, q = 0.f;
#pragma unroll
        for (int w = 0; w < 8; ++w) { s += part[(w * 128 + tid) * 2]; q += part[(w * 128 + tid) * 2 + 1]; }
        const float mean = s * (1.0f / 1024.0f); const float var = fmaxf(q * (1.0f / 1024.0f) - mean * mean, 0.f);
        mu[tid] = mean; rs[tid] = 1.0f / sqrtf(var + LN_EPS); }
    __syncthreads();
    const int g = half * 4 + (wave >> 1), th = wave & 1, nks = th ? 8 : 4;
    LAS float* c1s = cw + wave * 64; LAS float* c2s = c1s + 32;
    for (int tb = 0; tb < 2; ++tb) {
        const int t0 = th * 64 + tb * 32;
        f32x16 acc[4];
#pragma unroll
        for (int d = 0; d < 4; ++d)
#pragma unroll
            for (int r = 0; r < 16; ++r) acc[d][r] = 0.f;
        float c1 = 0.f, c2 = 0.f;
        const float* wrow = sgu_w + ((size_t)g * 128 + t0 + r32) * 128 + 8 * hi;
        const bf16_t* vb = SVT + (size_t)(g * 128 + r32) * M + m0 + 8 * hi;
        for (int ks = 0; ks < nks; ++ks) {
            const f32x4 w0 = *(const f32x4*)(wrow + 16 * ks), w1 = *(const f32x4*)(wrow + 16 * ks + 4);
            const int k0 = 16 * ks + 8 * hi;
            float wv[8] = {w0[0], w0[1], w0[2], w0[3], w1[0], w1[1], w1[2], w1[3]}, wp[8];
#pragma unroll
            for (int j = 0; j < 8; ++j) { wp[j] = wv[j] * rs[k0 + j]; c1 += wp[j] * mu[k0 + j]; c2 += wv[j]; }
            u32x4 ap; ap.x = pk2(wp[0], wp[1]); ap.y = pk2(wp[2], wp[3]); ap.z = pk2(wp[4], wp[5]); ap.w = pk2(wp[6], wp[7]);
            const bf16x8 af = __builtin_bit_cast(bf16x8, ap);
#pragma unroll
            for (int d = 0; d < 4; ++d) { const bf16x8 bf = *(const bf16x8*)(vb + (size_t)(d * 32) * M + 16 * ks);
                acc[d] = __builtin_amdgcn_mfma_f32_32x32x16_bf16(af, bf, acc[d], 0, 0, 0); }
        }
        c1 += __shfl_xor(c1, 32); c2 += __shfl_xor(c2, 32);
        if (hi == 0) { c1s[r32] = c1; c2s[r32] = c2; }
        LDS_WAIT(); asm volatile("" ::: "memory");
#pragma unroll
        for (int d = 0; d < 4; ++d) { const int ch = g * 128 + d * 32 + r32; const float gn = lng[ch], bs = lnb[ch];
#pragma unroll
            for (int r = 0; r < 16; ++r) { const int tl = crow(r, hi), t = t0 + tl;
                const float mixed = gn * (acc[d][r] - c1s[tl]) + bs * c2s[tl] + sgu_b[g * 128 + t];
                const size_t o = (m0 + t) * SGW + ch;
                const float uu = __uint_as_float((unsigned)SU[o] << 16);
                Ob[o] = (bf16_t)f2bf(uu * mixed); } }
        LDS_WAIT(); asm volatile("" ::: "memory");
    }
    __syncthreads();
}

struct Args { const float* in[23]; float* out; unsigned char* ws; int ph_lo, ph_hi; };
constexpr int NPHASE = 10;

__global__ void __launch_bounds__(NWAVES * 64, 2) mk_fwd(Args args) {
    extern __shared__ __attribute__((aligned(16))) unsigned char lds_raw[];
    LAS unsigned char* lds = (LAS unsigned char*)lds_raw;
    volatile LAS unsigned* MISC = (volatile LAS unsigned*)(lds + MISC_OFF);
    const int tid = threadIdx.x, lane = tid & 63, wave = __builtin_amdgcn_readfirstlane(tid >> 6);
    const int G = gridDim.x, bx = blockIdx.x;
    const int vcu = (G % 8 == 0) ? (bx % 8) * (G / 8) + bx / 8 : bx;
    const int gw = vcu * NWAVES + wave, NGW = G * NWAVES;
    unsigned char* ws = args.ws;
    unsigned* ctl = (unsigned*)(ws + WS_CTL);
    const float* x = args.in[0]; const float* cvec = args.in[1]; const float* w_ada = args.in[2]; const float* b_ada = args.in[3]; const float* w_in = args.in[4];
    const float* sgu_w = args.in[5]; const float* sgu_b = args.in[6]; const float* sgu_lng = args.in[7]; const float* sgu_lnb = args.in[8];
    const float* w_pa = args.in[9]; const float* w_pb = args.in[10]; const float* w_out = args.in[11]; const float* ln1g = args.in[12]; const float* ln1b = args.in[13];
    const float* w_group = args.in[14]; const float* b_group = args.in[15]; const float* w_router = args.in[16]; const float* b_router = args.in[17];
    const float* w_gate = args.in[18]; const float* w_up = args.in[19]; const float* w_down = args.in[20]; const float* ln2g = args.in[21]; const float* ln2b = args.in[22];
    float* modp = (float*)(ws + WS_MODP); float* mod = (float*)(ws + WS_MOD);
    int* toklist = (int*)(ws + WS_TOK); int* asg = (int*)(ws + WS_ASG);
    bf16_t* Wab = (bf16_t*)(ws + WS_WAB); bf16_t* Wout = (bf16_t*)(ws + WS_WOUT); bf16_t* Wgu = (bf16_t*)(ws + WS_WGU); bf16_t* Wd = (bf16_t*)(ws + WS_WD); bf16_t* Win = (bf16_t*)(ws + WS_WIN);
    bf16_t* Hb = (bf16_t*)(ws + WS_H); bf16_t* Qb = (bf16_t*)(ws + WS_Q); bf16_t* Kb = (bf16_t*)(ws + WS_K); bf16_t* SUb = (bf16_t*)(ws + WS_SU); bf16_t* VTb = (bf16_t*)(ws + WS_VT);
    bf16_t* MRG = (bf16_t*)(ws + WS_MRG); bf16_t* YS = (bf16_t*)(ws + WS_YS); bf16_t* SAb = (bf16_t*)(ws + WS_SA); bf16_t* SBb = (bf16_t*)(ws + WS_SB);
    float* V1 = (float*)(ws + WS_V1); bf16_t* OAB = (bf16_t*)(ws + WS_OAB); bf16_t* HBb = (bf16_t*)(ws + WS_HB);

    for (int u = tid; u < (LDS_BYTES - LDSCTL_OFF) / 4; u += NWAVES * 64) ((LAS unsigned*)(lds + LDSCTL_OFF))[u] = 0u;
    __syncthreads();
    XcdBarrier bar; bar.bar = ctl + CW_BAR; bar.x = 0; bar.st = nullptr;
#if !MK_PER_PHASE
    bar = xcd_barrier_post(ctl + CW_BAR, MISC + 8);
#define GRID_BAR() xcd_barrier(bar)
#else
#define GRID_BAR() do { } while (0)
#endif
    const int lo = args.ph_lo, hi_ph = args.ph_hi;
#ifndef PH_MASK
#define PH_MASK 0x3ff
#endif
#define IN(k) (((PH_MASK >> (k)) & 1) && lo <= (k) && (k) < hi_ph)
#define BOTH(k) (IN(k) && IN((k) + 1))

    if (IN(0)) {
        LAS float* sl = (LAS float*)lds;
        for (int item = vcu; item < 256; item += G) {
            const int cc = item & 31, ks = item >> 5;
            { const int b = tid >> 8, kk = tid & 255; const float v = cvec[b * DM + ks * 256 + kk]; sl[tid] = v / (1.0f + __expf(-v)); }
            __syncthreads();
            const int cg = tid % 96, sub = tid / 96;
            f32x4 a0 = {0.f, 0.f, 0.f, 0.f}, a1 = {0.f, 0.f, 0.f, 0.f};
            if (sub < 4) {
                const float* wp = w_ada + (size_t)(ks * 256 + sub * 64) * MODW + cc * 384 + cg * 4;
#pragma unroll 8
                for (int i = 0; i < 64; ++i) { const f32x4 w = *(const f32x4*)(wp + (size_t)i * MODW); a0 += w * sl[sub * 64 + i]; a1 += w * sl[256 + sub * 64 + i]; }
            }
            LAS float* red = sl + 512;
            if (sub < 4) { *(LAS f32x4*)(red + (sub * 2 + 0) * 384 + cg * 4) = a0; *(LAS f32x4*)(red + (sub * 2 + 1) * 384 + cg * 4) = a1; }
            __syncthreads();
            if (tid < 192) { const int b = tid / 96, gq = tid % 96; f32x4 s = {0.f, 0.f, 0.f, 0.f};
#pragma unroll
                for (int sb = 0; sb < 4; ++sb) s += *(LAS f32x4*)(red + (sb * 2 + b) * 384 + gq * 4);
                *(f32x4*)(modp + ((size_t)ks * 2 + b) * MODW + cc * 384 + gq * 4) = s; }
            __syncthreads();
        }
        LAS float* scr = (LAS float*)(lds + wave * 16384);
        constexpr int I_IN = 32 * 288, I_P = 16 * 64, I_O = 32 * 64, I_G = 32 * 16  , I_D = 8 * 64  ;
        constexpr int NITEMS = I_IN + 2 * I_P + I_O + NE * (2 * I_G + I_D);
        for (int it = gw; it < NITEMS; it += NGW) {
            int r = it;
            if (r < I_IN) { const int kb = r / 288, nb = r % 288; transpose_item(w_in, DM, INC, Win, 64 * kb, 32 * nb, win_dst(32 * nb) - 32 * nb, scr, lane); continue; } r -= I_IN;
            if (r < I_P) { const int kb = r / 64, nb = r % 64; transpose_item(w_pa, 1024, DM, Wab, 64 * kb, 32 * nb, 0, scr, lane); continue; } r -= I_P;
            if (r < I_P) { const int kb = r / 64, nb = r % 64; transpose_item(w_pb, 1024, DM, Wab, 64 * kb, 32 * nb, 2048, scr, lane); continue; } r -= I_P;
            if (r < I_O) { const int kb = r / 64, nb = r % 64; transpose_item(w_out, DM, DM, Wout, 64 * kb, 32 * nb, 0, scr, lane); continue; } r -= I_O;
            if (r < NE * I_G) { const int e = r / I_G, q = r % I_G, kb = q / 16, nb = q % 16, n0 = 32 * nb;
                transpose_item(w_gate + (size_t)e * DM * DE, DM, DE, Wgu + (size_t)e * 1024 * DM, 64 * kb, n0, 128 * (n0 / 128), scr, lane); continue; } r -= NE * I_G;
            if (r < NE * I_G) { const int e = r / I_G, q = r % I_G, kb = q / 16, nb = q % 16, n0 = 32 * nb;
                transpose_item(w_up + (size_t)e * DM * DE, DM, DE, Wgu + (size_t)e * 1024 * DM, 64 * kb, n0, 128 * (n0 / 128) + 128, scr, lane); continue; } r -= NE * I_G;
            { const int e = r / I_D, q = r % I_D, kb = q / 64, nb = q % 64;
                transpose_item(w_down + (size_t)e * DE * DM, DE, DM, Wd + (size_t)e * DM * DE, 64 * kb, 32 * nb, 0, scr, lane); }
        }
        if (BOTH(0)) GRID_BAR();
    }

    if (IN(1)) {
        LAS float* ms = (LAS float*)lds;
        for (int idx = tid; idx < 8192; idx += NWAVES * 64) { const int b = idx >> 12, j = idx & 4095; float v = b_ada[j];
#pragma unroll
            for (int p = 0; p < 8; ++p) v += modp[((size_t)p * 2 + b) * MODW + j];
            ms[idx] = (j >= DM) ? 1.0f + v : v; }
        for (int idx = vcu * (NWAVES * 64) + tid; idx < 2 * MODW; idx += G * NWAVES * 64) { const int b = idx / MODW, j = idx % MODW; float v = b_ada[j];
#pragma unroll
            for (int p = 0; p < 8; ++p) v += modp[((size_t)p * 2 + b) * MODW + j];
            mod[idx] = v; }
        __syncthreads();
        for (int m = gw; m < M; m += NGW) {
            const int b = m >> 13;
            const f32x4* xr = (const f32x4*)(x + (size_t)m * DM) + lane;
            f32x4 v[8]; float s = 0.f;
#pragma unroll
            for (int j = 0; j < 8; ++j) { v[j] = xr[64 * j]; s += (v[j].x + v[j].y) + (v[j].z + v[j].w); }
            const float mean = wave_sum(s) * (1.0f / DM); float s2 = 0.f;
#pragma unroll
            for (int j = 0; j < 8; ++j) { v[j] = v[j] - mean; s2 += (v[j].x * v[j].x + v[j].y * v[j].y) + (v[j].z * v[j].z + v[j].w * v[j].w); }
            const float rstd = 1.0f / sqrtf(wave_sum(s2) * (1.0f / DM) + LN_EPS);
            u32x2* o8 = (u32x2*)(Hb + (size_t)m * DM) + lane;
#pragma unroll
            for (int j = 0; j < 8; ++j) { const f32x4 sh = *(const LAS f32x4*)(ms + (b * 2) * DM + 256 * j + 4 * lane), sc = *(const LAS f32x4*)(ms + (b * 2 + 1) * DM + 256 * j + 4 * lane);
                const f32x4 hv = v[j] * rstd * sc + sh; u32x2 w; w.x = pk2(hv.x, hv.y); w.y = pk2(hv.z, hv.w); o8[64 * j] = w; }
        }
        __syncthreads();
        if (BOTH(1)) GRID_BAR();
    }

    if (IN(2)) {
        { pg8::Gemm g{Hb, Win, DM}; pg8::StaticOrder S; S.init(M, N1, G, bx);
          pg8::EpiG1 E{Qb, Kb, SUb, SAb, SBb};
          pg8::gemm_phase<pg8::EpiG1, pg8::StaticOrder, true>(lds, g, S, E); }
        { pg8::Gemm g{Win + (size_t)N1 * DM, Hb, DM}; pg8::StaticOrder S; S.init(2048, M, G, bx);
          pg8::EpiG2 E{VTb};
          pg8::gemm_phase<pg8::EpiG2, pg8::StaticOrder, true>(lds, g, S, E); }
        if (BOTH(2)) GRID_BAR();
    }

    if (IN(3)) {
        for (int item = vcu; item < 256; item += G)
            sgu_item(item >> 1, item & 1, VTb + (size_t)1024 * M, SUb, sgu_w, sgu_b, sgu_lng, sgu_lnb, OAB + (size_t)M * SBW, lds, tid);
        for (int U = gw; U < BATCH * NHEAD * (SEQ / 32); U += NGW) {
            const int bh = U >> 8, qb = U & 255;
            sb_attn_unit(bh >> 3, bh & 7, qb, Qb, Kb, VTb, OAB, lane);
        }
        if (BOTH(3)) GRID_BAR();
    }

    if (IN(4)) {
        pg8::Gemm g{OAB, Wab, 1024}; pg8::PairOrder S; S.so.init(M, DM, G, bx);
        pg8::EpiGate E{SAb, SBb, MRG};
        pg8::gemm_phase<pg8::EpiGate, pg8::PairOrder, true>(lds, g, S, E);
        if (BOTH(4)) GRID_BAR();
    }

    if (IN(5)) {
        pg8::Gemm g{MRG, Wout, DM}; pg8::StaticOrder S; S.init(M, DM, G, bx);
        pg8::EpiV1 E{x, mod, V1};
        pg8::gemm_phase<pg8::EpiV1, pg8::StaticOrder, true>(lds, g, S, E);
        if (BOTH(5)) GRID_BAR();
    }

    if (IN(6)) {
        LAS float* wl = (LAS float*)lds;
        for (int it = vcu; it < M / 16; it += G) {
            const int mbase = it * 16 + wave * 2;
            float mean2[2], rstd2[2];
#pragma unroll
            for (int rr = 0; rr < 2; ++rr) {
                const int m = mbase + rr, b = m >> 13;
                int lane_o = lane; asm volatile("" : "+v"(lane_o));
                f32x2* vr = (f32x2*)(V1 + (size_t)m * DM) + lane_o;
                f32x2 v[16]; float s = 0.f;
#pragma unroll
                for (int j = 0; j < 16; ++j) { v[j] = vr[64 * j]; s += v[j].x + v[j].y; }
                float mean = wave_sum(s) * (1.0f / DM); float s2 = 0.f;
#pragma unroll
                for (int j = 0; j < 16; ++j) { v[j] = v[j] - mean; s2 += v[j].x * v[j].x + v[j].y * v[j].y; }
                float rstd = 1.0f / sqrtf(wave_sum(s2) * (1.0f / DM) + LN_EPS);
                s = 0.f;
#pragma unroll
                for (int j = 0; j < 16; ++j) { const f32x2 gq = *((const f32x2*)ln1g + 64 * j + lane_o), bq = *((const f32x2*)ln1b + 64 * j + lane_o);
                    v[j] = v[j] * rstd * gq + bq; vr[64 * j] = v[j]; s += v[j].x + v[j].y; }
                mean = wave_sum(s) * (1.0f / DM); s2 = 0.f;
#pragma unroll
                for (int j = 0; j < 16; ++j) { const f32x2 d = v[j] - mean; s2 += d.x * d.x + d.y * d.y; }
                rstd = 1.0f / sqrtf(wave_sum(s2) * (1.0f / DM) + LN_EPS);
                mean2[rr] = mean; rstd2[rr] = rstd;
                const f32x2* sh2 = (const f32x2*)(mod + (size_t)b * MODW + 3 * DM); const f32x2* sc2 = (const f32x2*)(mod + (size_t)b * MODW + 4 * DM);
                unsigned* ho = (unsigned*)(Hb + (size_t)m * DM) + lane_o;
#pragma unroll
                for (int j = 0; j < 16; ++j) { const f32x2 a = sh2[64 * j + lane_o], c = sc2[64 * j + lane_o];
                    const f32x2 hv = (v[j] - mean) * rstd * (c + 1.0f) + a; ho[64 * j] = pk2(hv.x, hv.y); }
            }
            float lg[2][36];
#pragma unroll
            for (int rr = 0; rr < 2; ++rr)
#pragma unroll
                for (int c = 0; c < 36; ++c) lg[rr][c] = 0.f;
            const int bq_ = mbase >> 13;
            const f32x2* sh2q = (const f32x2*)(mod + (size_t)bq_ * MODW + 3 * DM) + lane; const f32x2* sc2q = (const f32x2*)(mod + (size_t)bq_ * MODW + 4 * DM) + lane;
            const f32x2* x1a = (const f32x2*)(V1 + (size_t)mbase * DM) + lane; const f32x2* x1b = x1a + DM / 2;
#pragma unroll 1
            for (int j = 0; j < 16; ++j) {
                __syncthreads();
                for (int idx = tid; idx < 128 * 9; idx += NWAVES * 64) { const int kk = idx / 9, q4 = idx % 9, k = 128 * j + kk;
                    const f32x4 w = (q4 < 8) ? *(const f32x4*)(w_router + (size_t)k * 32 + 4 * q4) : *(const f32x4*)(w_group + (size_t)k * 4);
                    *(LAS f32x4*)(wl + ((kk >> 1) + 64 * (kk & 1)) * 36 + 4 * q4) = w; }
                const f32x2 xa = x1a[64 * j], xb = x1b[64 * j], sh = sh2q[64 * j], sc = sc2q[64 * j] + 1.0f;
                const f32x2 ha2 = (xa - mean2[0]) * rstd2[0] * sc + sh, hb2 = (xb - mean2[1]) * rstd2[1] * sc + sh;
                __syncthreads();
#pragma unroll
                for (int e = 0; e < 2; ++e) {
                    const LAS f32x4* wr4 = (const LAS f32x4*)(wl + (lane + 64 * e) * 36);
                    const float ha = e ? ha2.y : ha2.x, hb1 = e ? hb2.y : hb2.x;
#pragma unroll
                    for (int q4 = 0; q4 < 9; ++q4) { const f32x4 w = wr4[q4];
#pragma unroll
                        for (int i = 0; i < 4; ++i) { lg[0][4 * q4 + i] += ha * w[i]; lg[1][4 * q4 + i] += hb1 * w[i]; } }
                }
            }
#pragma unroll
            for (int rr = 0; rr < 2; ++rr)
#pragma unroll
                for (int c = 0; c < 36; ++c) lg[rr][c] = wave_sum(lg[rr][c]);
            if (lane < 2) {
                const int m = mbase + lane;
                float l[36];
#pragma unroll
                for (int c = 0; c < 36; ++c) l[c] = (lane == 0 ? lg[0][c] : lg[1][c]) + (c < 32 ? b_router[c] : b_group[c - 32]);
                int gs = 0; float gm = l[32];
#pragma unroll
                for (int q = 1; q < 4; ++q) if (l[32 + q] > gm) { gm = l[32 + q]; gs = q; }
                float den = 0.f;
#pragma unroll
                for (int q = 0; q < 4; ++q) den += __expf(l[32 + q] - gm);
                const float pg = 1.0f / den;
                int i0 = 0, i1 = 1; float v0 = 0.f, v1 = 0.f;
#pragma unroll
                for (int q = 0; q < 4; ++q) {
                    int a0 = 0; float b0 = l[8 * q];
#pragma unroll
                    for (int j = 1; j < 8; ++j) if (l[8 * q + j] > b0) { b0 = l[8 * q + j]; a0 = j; }
                    int a1 = -1; float b1 = -3.0e38f;
#pragma unroll
                    for (int j = 0; j < 8; ++j) if (j != a0 && l[8 * q + j] > b1) { b1 = l[8 * q + j]; a1 = j; }
                    if (q == gs) { i0 = a0; i1 = a1; v0 = b0; v1 = b1; }
                }
                const float e1 = __expf(v1 - v0), w0 = pg / (1.0f + e1), w1 = pg * e1 / (1.0f + e1);
                const int x0 = gs * 8 + i0, x1 = gs * 8 + i1;
                const int p0 = (int)atomicAdd(ctl + CW_CNT + x0, 1u), p1 = (int)atomicAdd(ctl + CW_CNT + x1, 1u);
                toklist[x0 * ECAP + p0] = m; toklist[x1 * ECAP + p1] = m;
                int* ag = asg + (size_t)m * 8;
                ag[0] = x0; ag[1] = p0; ag[2] = __float_as_int(w0); ag[3] = 0; ag[4] = x1; ag[5] = p1; ag[6] = __float_as_int(w1); ag[7] = 0;
            }
        }
        __syncthreads();
        if (BOTH(6)) GRID_BAR();
    }

    LAS int* tp = (LAS int*)(lds + LDSCTL_OFF);
#define BUILD_TP() do { __syncthreads(); if (tid == 0) { int acc_ = 0; for (int e_ = 0; e_ < NE; ++e_) { const int c_ = (int)__hip_atomic_load(ctl + CW_CNT + e_, RLX_AGENT); tp[e_] = acc_; tp[40 + e_] = c_; acc_ += (c_ + 255) >> 8; } tp[32] = acc_; } __syncthreads(); } while (0)

    if (IN(7)) {
        BUILD_TP();
        pg8::Gemm g{Hb, Wgu, DM}; pg8::MoeOrder<true, 2> S{tp, toklist, G, bx, tp[32] * 4};
        pg8::EpiGU E{HBb};
        pg8::gemm_phase<pg8::EpiGU, pg8::MoeOrder<true, 2>, true>(lds, g, S, E);
        if (BOTH(7)) GRID_BAR();
    }

    if (IN(8)) {
        BUILD_TP();
        pg8::Gemm g{HBb, Wd, DE}; pg8::MoeOrder<false, 3> S{tp, toklist, G, bx, tp[32] * 8};
        pg8::EpiDown E{YS};
        pg8::gemm_phase<pg8::EpiDown, pg8::MoeOrder<false, 3>, true>(lds, g, S, E);
        if (BOTH(8)) GRID_BAR();
    }

    if (IN(9)) {
        BUILD_TP();
        for (int m = gw; m < M; m += NGW) {
            const int b = m >> 13;
            const int* ag = asg + (size_t)m * 8;
            const int e0 = ag[0], p0 = ag[1], e1 = ag[4], p1 = ag[5]; const float w0 = __int_as_float(ag[2]), w1 = __int_as_float(ag[6]);
            const size_t r0 = (size_t)tp[e0] * 256 + p0, r1 = (size_t)tp[e1] * 256 + p1;
            const f32x4* xr = (const f32x4*)(V1 + (size_t)m * DM) + lane;
            const u32x2* y0 = (const u32x2*)(YS + r0 * DM) + lane; const u32x2* y1 = (const u32x2*)(YS + r1 * DM) + lane;
            const f32x4* g2 = (const f32x4*)(mod + (size_t)b * MODW + 5 * DM) + lane;
            f32x4 v[8]; float s = 0.f;
#pragma unroll
            for (int j = 0; j < 8; ++j) { const f32x4 xv = xr[64 * j], gq = g2[64 * j]; const u32x2 a = y0[64 * j], c = y1[64 * j];
                const f32x4 ya = {bflo(a.x), bfhi(a.x), bflo(a.y), bfhi(a.y)}, yc = {bflo(c.x), bfhi(c.x), bflo(c.y), bfhi(c.y)};
                v[j] = xv * ALPHA + gq * (ya * w0 + yc * w1); s += (v[j].x + v[j].y) + (v[j].z + v[j].w); }
            const float mean = wave_sum(s) * (1.0f / DM); float s2 = 0.f;
#pragma unroll
            for (int j = 0; j < 8; ++j) { v[j] = v[j] - mean; s2 += (v[j].x * v[j].x + v[j].y * v[j].y) + (v[j].z * v[j].z + v[j].w * v[j].w); }
            const float rstd = 1.0f / sqrtf(wave_sum(s2) * (1.0f / DM) + LN_EPS);
            f32x4* orow = (f32x4*)(args.out + (size_t)m * DM) + lane;
#pragma unroll
            for (int j = 0; j < 8; ++j) { const f32x4 gq = *((const f32x4*)ln2g + 64 * j + lane), bq = *((const f32x4*)ln2b + 64 * j + lane); orow[64 * j] = v[j] * rstd * gq + bq; }
        }
    }
#undef IN
#undef BOTH
}

extern "C" void kernel_launch(void* const* d_in, const int* in_sizes, int n_in, void* d_out, int out_size, void* d_ws, size_t ws_size, hipStream_t stream) {
    static int grid = 0;
    if (grid == 0) {
        if (n_in != 23 || in_sizes[0] != M * DM || out_size != M * DM || ws_size < WS_END) {
            fprintf(stderr, "kernel_launch: unexpected shapes (n_in %d, in0 %d, out %d, ws %zu); nothing launched\n", n_in, n_in > 0 ? in_sizes[0] : -1, out_size, ws_size); grid = -1; return; }
        int dev = 0, cus = 0, per_cu = 0;
        if (hipGetDevice(&dev) != hipSuccess || hipDeviceGetAttribute(&cus, hipDeviceAttributeMultiprocessorCount, dev) != hipSuccess) { fprintf(stderr, "kernel_launch: device query failed\n"); grid = -1; return; }
        if (hipFuncSetAttribute((const void*)mk_fwd, hipFuncAttributeMaxDynamicSharedMemorySize, LDS_BYTES) != hipSuccess) { fprintf(stderr, "kernel_launch: hipFuncSetAttribute failed\n"); grid = -1; return; }
        if (hipOccupancyMaxActiveBlocksPerMultiprocessor(&per_cu, (const void*)mk_fwd, NWAVES * 64, LDS_BYTES) != hipSuccess || per_cu < 1)
            fprintf(stderr, "kernel_launch: note: occupancy query reports %d workgroups per CU\n", per_cu);
        (void)hipGetLastError();
        grid = cus;
    }
    if (grid < 0) return;
    if (hipMemsetAsync((char*)d_ws + WS_CTL, 0, CTL_ZERO_BYTES, stream) != hipSuccess) { fprintf(stderr, "kernel_launch: memset failed\n"); return; }
    Args a{};
    for (int i = 0; i < 23; ++i) a.in[i] = (const float*)d_in[i];
    a.out = (float*)d_out; a.ws = (unsigned char*)d_ws;
#if MK_PER_PHASE
    for (int p = 0; p < NPHASE; ++p) { a.ph_lo = p; a.ph_hi = p + 1; hipLaunchKernelGGL(mk_fwd, dim3(grid), dim3(NWAVES * 64), LDS_BYTES, stream, a); }
#else
    a.ph_lo = 0; a.ph_hi = NPHASE;
    hipLaunchKernelGGL(mk_fwd, dim3(grid), dim3(NWAVES * 64), LDS_BYTES, stream, a);
#endif
    const hipError_t le = hipPeekAtLastError();
    if (le != hipSuccess) fprintf(stderr, "kernel_launch: launch failed: %s\n", hipGetErrorName(le));
}
```

```cpp
#include <hip/hip_runtime.h>
#include <cstdio>
#include <cstdint>

#ifndef MK_PER_PHASE
#define MK_PER_PHASE 0
#endif

#define GAS __attribute__((address_space(1)))
#define LAS __attribute__((address_space(3)))
typedef unsigned short bf16_t;
typedef short bf16x8 __attribute__((ext_vector_type(8)));
typedef short s16x4 __attribute__((ext_vector_type(4)));
typedef float f32x2 __attribute__((ext_vector_type(2)));
typedef float f32x4 __attribute__((ext_vector_type(4)));
typedef float f32x16 __attribute__((ext_vector_type(16)));
typedef unsigned u32x2 __attribute__((ext_vector_type(2)));
typedef unsigned u32x4 __attribute__((ext_vector_type(4)));
typedef __bf16 bf16x2_t __attribute__((ext_vector_type(2)));

constexpr int BATCH = 2, SEQ = 8192, DM = 2048, M = BATCH * SEQ;
constexpr int NHEAD = 8, HD = 128, SBW = 1024, SGW = 1024;
constexpr int INC = 9216, N1 = 7168;
constexpr int NE = 32, DE = 512, ECAP = 16384;
constexpr int MODW = 6 * DM;
constexpr float LN_EPS = 1e-5f;
constexpr float ALPHA = 1.189207115002721f;
constexpr float QSCALE = 0.08838834764831845f * 1.4426950408889634f;
constexpr int VTP = M + 128;
constexpr int HBROWS = 40960;

constexpr size_t MiB = 1u << 20;
constexpr size_t WS_CTL = 0, CTL_ZERO_BYTES = 32768;
constexpr size_t WS_MODP = 1 * MiB;
constexpr size_t WS_MOD = 2 * MiB;
constexpr size_t WS_WRT = 2 * MiB + 256 * 1024;
constexpr size_t WS_TOK = 3 * MiB;
constexpr size_t WS_ASG = 5 * MiB;
constexpr size_t WS_WAB = 6 * MiB;
constexpr size_t WS_WOUT = 14 * MiB;
constexpr size_t WS_WGU = 22 * MiB;
constexpr size_t WS_WD = 150 * MiB;
constexpr size_t WS_WIN = 214 * MiB;
constexpr size_t WS_H = 250 * MiB;
constexpr size_t WS_Q = 314 * MiB, WS_K = 346 * MiB, WS_SU = 378 * MiB, WS_VT = 410 * MiB;
constexpr size_t WS_MRG = 314 * MiB;
constexpr size_t WS_YS = 314 * MiB;
constexpr size_t WS_SA = 475 * MiB, WS_SB = 539 * MiB;
constexpr size_t WS_V1 = 475 * MiB;
constexpr size_t WS_OAB = 603 * MiB;
constexpr size_t WS_HB = 603 * MiB;
constexpr size_t WS_END = 667 * MiB;
constexpr int CW_CNT = 64;
constexpr int CW_MODC = 3008;
constexpr int CW_BAR = 4096;

constexpr int RING_BYTES = 131072;
constexpr int LDSCTL_OFF = RING_BYTES, MISC_OFF = LDSCTL_OFF + 320;
constexpr int LDS_BYTES = 147456;
constexpr int NWAVES = 8;

#define RLX_AGENT __ATOMIC_RELAXED, __HIP_MEMORY_SCOPE_AGENT
#define LDS_WAIT() asm volatile("s_waitcnt lgkmcnt(0)" ::: "memory")
__device__ __forceinline__ unsigned f2bf(float f) { unsigned u = __builtin_bit_cast(unsigned, f); return (u + 0x7fffu + ((u >> 16) & 1u)) >> 16; }
__device__ __forceinline__ unsigned pk2(float lo, float hi) { f32x2 v = {lo, hi}; bf16x2_t b = __builtin_convertvector(v, bf16x2_t); return __builtin_bit_cast(unsigned, b); }
__device__ __forceinline__ unsigned pk4_fp8(float a, float b, float c, float d) { int p = __builtin_amdgcn_cvt_pk_fp8_f32(a, b, 0, false); p = __builtin_amdgcn_cvt_pk_fp8_f32(c, d, p, true); return (unsigned)p; }
__device__ __forceinline__ float bflo(unsigned u) { return __uint_as_float(u << 16); }
__device__ __forceinline__ float bfhi(unsigned u) { return __uint_as_float(u & 0xffff0000u); }
template <int CTRL> __device__ __forceinline__ float dpp_mov(float v) { return __int_as_float(__builtin_amdgcn_update_dpp(0, __float_as_int(v), CTRL, 0xF, 0xF, false)); }
__device__ __forceinline__ float xor16_sum(float v) { auto r = __builtin_amdgcn_permlane16_swap(__float_as_uint(v), __float_as_uint(v), false, false); return __uint_as_float(r[0]) + __uint_as_float(r[1]); }
__device__ __forceinline__ float xor32_sum(float v) { auto r = __builtin_amdgcn_permlane32_swap(__float_as_uint(v), __float_as_uint(v), false, false); return __uint_as_float(r[0]) + __uint_as_float(r[1]); }
__device__ __forceinline__ float xor32_get(float v, int hi) { auto r = __builtin_amdgcn_permlane32_swap(__float_as_uint(v), __float_as_uint(v), false, false); return __uint_as_float(hi ? r[0] : r[1]); }
__device__ __forceinline__ float wave_sum(float v) {
    v += dpp_mov<0xB1>(v);
    v += dpp_mov<0x4E>(v);
    v += dpp_mov<0x124>(v);
    v += dpp_mov<0x128>(v);
    v = xor16_sum(v);
    return xor32_sum(v);
}
__device__ __forceinline__ float sigmoidf_(float x) { return __builtin_amdgcn_rcpf(1.0f + __builtin_amdgcn_exp2f(-1.4426950408889634f * x)); }
__device__ __forceinline__ f32x2 gelu_pk(f32x2 v) {
    const f32x2 av = __builtin_elementwise_abs(v), d = av * 0.2316418882f + 1.0f;
    f32x2 t; t.x = __builtin_amdgcn_rcpf(d.x); t.y = __builtin_amdgcn_rcpf(d.y);
    f32x2 q = t * 0.5307027145f + (-0.7265760135f); q = q * t + 0.7107068705f; q = q * t + (-0.142248368f); q = q * t + 0.127414796f; q = q * t;
    const f32x2 s = (v * v) * (-0.72134752044f);
    f32x2 e; e.x = __builtin_amdgcn_exp2f(s.x); e.y = __builtin_amdgcn_exp2f(s.y);
    const f32x2 m = v * (q * e), r = v - m;
    f32x2 o; o.x = v.x < 0.f ? m.x : r.x; o.y = v.y < 0.f ? m.y : r.y; return o;
}
__device__ __forceinline__ int xcd_remap(int L, int nwg) { const int q = nwg / 8, r = nwg % 8, xcd = L % 8, off = L / 8; return (xcd < r ? xcd * (q + 1) : r * (q + 1) + (xcd - r) * q) + off; }

#ifndef GP_PROBE
#define GP_PROBE 0
#endif
#ifndef GP_PROBE_EPI
#define GP_PROBE_EPI EpiGate
#endif
#define GP_ACC(slot) do { if constexpr (GP_PROBE && __is_same(Epi, GP_PROBE_EPI)) { if (tid == 0) { volatile LAS unsigned long long* t_ = (volatile LAS unsigned long long*)(lds + 131072 + 1024); const unsigned long long n_ = __builtin_amdgcn_s_memrealtime(); t_[slot] += n_ - t_[18]; t_[18] = n_; } } } while (0)
namespace pg8 {
constexpr int BM = 256, BK = 64, HALF = 128, HTB = HALF * BK * 2, STAGE_BYTES = 8 * HTB, NXCD = 8, WGM = 8;
__host__ __device__ __forceinline__ int lds_byte(int r, int c) { const int st = (r >> 4) * 2 + (c >> 5), rr = r & 15, cc = c & 31, ob = rr * 64 + cc * 2; return st * 1024 + (ob ^ (((ob >> 9) & 1) << 5)); }
__host__ __device__ __forceinline__ void stage_rc(int b, int& R, int& C) { const int st = b / 1024, sb = b % 1024, swz = sb ^ (((sb >> 9) & 1) << 5); R = (st >> 1) * 16 + swz / 64; C = (st & 1) * 32 + (swz % 64) / 2; }
__host__ __device__ __forceinline__ int perm32(int rho) { const int n = rho >> 4, i = rho & 15; return 8 * (i >> 2) + 4 * n + (i & 3); }

struct Unit { int pm, pn, ax, ax2; };
struct Gemm { const bf16_t* A; const bf16_t* Bt; int K; };

struct StaticOrder {
    static constexpr bool GATHER = false;
    int nM, nN, nwg, G, c;
    __device__ void init(int Mr, int Nr, int G_, int c_) { nM = Mr / BM; nN = Nr / BM; nwg = nM * nN; G = G_; c = c_; }
    __device__ bool next(int i, Unit& u) const {
        const long L = (long)i * G + c; if (L >= nwg) return false;
        const int wgid = xcd_remap((int)L, nwg);
        const int nig = WGM * nN, gid = wgid / nig, fm = gid * WGM, gsz = (nM - fm) < WGM ? (nM - fm) : WGM;
        u.pm = fm + ((wgid % nig) % gsz); u.pn = (wgid % nig) / gsz; u.ax = 0; u.ax2 = 0; return true;
    }
    __device__ __forceinline__ int row_src(const Unit&, int) const { return 0; }
};
struct PairOrder {
    static constexpr bool GATHER = false;
    StaticOrder so;
    __device__ bool next(int i, Unit& u) const { Unit t; if (!so.next(i >> 1, t)) return false; const int hf = i & 1; u.pm = t.pm + 64 * hf; u.pn = t.pn + 8 * hf; u.ax = hf; u.ax2 = 0; return true; }
    __device__ __forceinline__ int row_src(const Unit&, int) const { return 0; }
};
template <bool G_, int SH> struct MoeOrder {
    static constexpr bool GATHER = G_;
    const LAS int* tp;
    const int* tok;
    int G, c, total;
    __device__ bool next(int i, Unit& u) const {
        const long L = (long)i * G + c; if (L >= total) return false;
        const int wgid = xcd_remap((int)L, total);
        const int tile = wgid >> SH, pn = wgid & ((1 << SH) - 1);
        int e = 0;
#pragma unroll 8
        for (int j = 1; j < NE; ++j) e += (tp[j] <= tile) ? 1 : 0;
        const int mt = tile - tp[e]; int valid = tp[40 + e] - mt * 256; valid = valid > 256 ? 256 : valid;
        u.pm = tile; u.pn = (e << SH) + pn; u.ax = e * ECAP + mt * 256; u.ax2 = valid; return true;
    }
    __device__ __forceinline__ int row_src(const Unit& u, int r) const { return r < u.ax2 ? tok[u.ax + r] : 0; }
};

__device__ __forceinline__ unsigned cvt_pk_bf16(float lo, float hi) { return pk2(lo, hi); }

#define PG8_ACC f32x4 (&acc)[2][2][4][2]

struct EpiG1 {
    static constexpr bool PERM = true, KEEP = false;
    bf16_t *q, *k, *su, *sa, *sb;
    __device__ __forceinline__ bool keep(const Unit&) const { return false; }
    __device__ __forceinline__ void prefetch(const Unit&, int, unsigned (&pf)[4]) const { pf[0] = pf[1] = pf[2] = pf[3] = 0u; }
    __device__ __forceinline__ void operator()(PG8_ACC, const Unit& u, int wr, int wc, int fr, int fq) const {
        bf16_t* base; int ldc, ct, mode;
        if (u.pn < 4) { base = q; ldc = 1024; ct = u.pn; mode = 0; }
        else if (u.pn < 8) { base = k; ldc = 1024; ct = u.pn - 4; mode = 1; }
        else if (u.pn < 12) { base = su; ldc = 1024; ct = u.pn - 8; mode = 2; }
        else if (u.pn < 20) { base = sa; ldc = 2048; ct = u.pn - 12; mode = 3; }
        else { base = sb; ldc = 2048; ct = u.pn - 20; mode = 3; }
        const int row0 = u.pm * BM + wr * 64 + fr, col0 = ct * BM + wc * 32 + 8 * fq;
#pragma unroll
        for (int ai = 0; ai < 2; ++ai)
#pragma unroll
            for (int m = 0; m < 4; ++m) { bf16_t* rowp = base + (size_t)(row0 + ai * HALF + m * 16) * ldc + col0;
#pragma unroll
                for (int bj = 0; bj < 2; ++bj) { f32x4 v0 = acc[ai][bj][m][0], v1 = acc[ai][bj][m][1];
                    if (mode == 0) { v0 = v0 * QSCALE; v1 = v1 * QSCALE; }
                    else if (mode == 2) { f32x2 a = gelu_pk((f32x2){v0[0], v0[1]}), b = gelu_pk((f32x2){v0[2], v0[3]}), c = gelu_pk((f32x2){v1[0], v1[1]}), d = gelu_pk((f32x2){v1[2], v1[3]});
                        v0 = (f32x4){a.x, a.y, b.x, b.y}; v1 = (f32x4){c.x, c.y, d.x, d.y}; }
                    else if (mode == 3) {
#pragma unroll
                        for (int j = 0; j < 4; ++j) { v0[j] = sigmoidf_(v0[j]); v1[j] = sigmoidf_(v1[j]); } }
                    u32x4 w; w.x = cvt_pk_bf16(v0[0], v0[1]); w.y = cvt_pk_bf16(v0[2], v0[3]); w.z = cvt_pk_bf16(v1[0], v1[1]); w.w = cvt_pk_bf16(v1[2], v1[3]);
                    *(u32x4*)(rowp + bj * HALF) = w; } }
    }
};
struct EpiGates {
    static constexpr bool PERM = true, KEEP = false;
    bf16_t *sa  , *sb, *su;
    __device__ __forceinline__ bool keep(const Unit&) const { return false; }
    __device__ __forceinline__ void prefetch(const Unit&, int, unsigned (&pf)[4]) const { pf[0] = pf[1] = pf[2] = pf[3] = 0u; }
    __device__ __forceinline__ void operator()(PG8_ACC, const Unit& u, int wr, int wc, int fr, int fq) const {
        { int t_ = threadIdx.x; asm volatile("" : "+v"(t_)); fr = t_ & 15; fq = (t_ >> 4) & 3; }
        if (u.pn >= 16) {
            const int row0 = u.pm * BM + wr * 64 + fr, col0 = (u.pn - 16) * BM + wc * 32 + 8 * fq;
#pragma unroll
            for (int ai = 0; ai < 2; ++ai)
#pragma unroll
                for (int m = 0; m < 4; ++m) { bf16_t* rowp = su + (size_t)(row0 + ai * HALF + m * 16) * SGW + col0;
#pragma unroll
                    for (int bj = 0; bj < 2; ++bj) { const f32x4 v0 = acc[ai][bj][m][0], v1 = acc[ai][bj][m][1];
                        const f32x2 a = gelu_pk((f32x2){v0[0], v0[1]}), b = gelu_pk((f32x2){v0[2], v0[3]}), c = gelu_pk((f32x2){v1[0], v1[1]}), d = gelu_pk((f32x2){v1[2], v1[3]});
                        u32x4 w; w.x = cvt_pk_bf16(a.x, a.y); w.y = cvt_pk_bf16(b.x, b.y); w.z = cvt_pk_bf16(c.x, c.y); w.w = cvt_pk_bf16(d.x, d.y);
                        *(u32x4*)(rowp + bj * HALF) = w; } }
        } else {
            const int row0 = u.pm * BM + wr * 64 + fr, col0 = u.pn * HALF + wc * 32 + 8 * fq;
#pragma unroll
            for (int ai = 0; ai < 2; ++ai)
#pragma unroll
                for (int m = 0; m < 4; ++m) { const size_t off = (size_t)(row0 + ai * HALF + m * 16) * DM + col0;
                    float rr[8], ss[8];
#pragma unroll
                    for (int n = 0; n < 2; ++n)
#pragma unroll
                        for (int j = 0; j < 4; ++j) { const float ea = __builtin_amdgcn_exp2f(-1.4426950408889634f * acc[ai][0][m][n][j]), eb = fminf(__builtin_amdgcn_exp2f(-1.4426950408889634f * acc[ai][1][m][n][j]), 1e30f);
                            ss[4 * n + j] = __builtin_amdgcn_rcpf(1.0f + eb); rr[4 * n + j] = (1.0f + eb) * __builtin_amdgcn_rcpf(1.0f + ea); }
                    u32x4 w; w.x = cvt_pk_bf16(rr[0], rr[1]); w.y = cvt_pk_bf16(rr[2], rr[3]); w.z = cvt_pk_bf16(rr[4], rr[5]); w.w = cvt_pk_bf16(rr[6], rr[7]);
                    *(u32x4*)(sa + off) = w;
                    w.x = cvt_pk_bf16(ss[0], ss[1]); w.y = cvt_pk_bf16(ss[2], ss[3]); w.z = cvt_pk_bf16(ss[4], ss[5]); w.w = cvt_pk_bf16(ss[6], ss[7]);
                    *(u32x4*)(sb + off) = w; }
        }
    }
};
struct EpiG2 {
    static constexpr bool PERM = true, KEEP = false;
    bf16_t* vt;
    __device__ __forceinline__ bool keep(const Unit&) const { return false; }
    __device__ __forceinline__ void prefetch(const Unit&, int, unsigned (&pf)[4]) const { pf[0] = pf[1] = pf[2] = pf[3] = 0u; }
    __device__ __forceinline__ void operator()(PG8_ACC, const Unit& u, int wr, int wc, int fr, int fq) const {
        { int t_ = threadIdx.x; asm volatile("" : "+v"(t_)); fr = t_ & 15; fq = (t_ >> 4) & 3; }
        const int row0 = u.pm * BM + wr * 64 + fr, col0 = u.pn * BM + wc * 32 + 8 * fq; const bool gl = u.pm >= 4;
#pragma unroll
        for (int ai = 0; ai < 2; ++ai)
#pragma unroll
            for (int m = 0; m < 4; ++m) { bf16_t* rowp = vt + (size_t)(row0 + ai * HALF + m * 16) * VTP + col0;
#pragma unroll
                for (int bj = 0; bj < 2; ++bj) { f32x4 v0 = acc[ai][bj][m][0], v1 = acc[ai][bj][m][1];
                    if (gl) { f32x2 a = gelu_pk((f32x2){v0[0], v0[1]}), b = gelu_pk((f32x2){v0[2], v0[3]}), c = gelu_pk((f32x2){v1[0], v1[1]}), d = gelu_pk((f32x2){v1[2], v1[3]});
                        v0 = (f32x4){a.x, a.y, b.x, b.y}; v1 = (f32x4){c.x, c.y, d.x, d.y}; }
                    u32x4 w; w.x = cvt_pk_bf16(v0[0], v0[1]); w.y = cvt_pk_bf16(v0[2], v0[3]); w.z = cvt_pk_bf16(v1[0], v1[1]); w.w = cvt_pk_bf16(v1[2], v1[3]);
                    *(u32x4*)(rowp + bj * HALF) = w; } }
    }
};
struct EpiGate {
    static constexpr bool PERM = true, KEEP = true;
    const bf16_t *sa  , *sb; bf16_t* O;
    __device__ __forceinline__ bool keep(const Unit& u) const { return u.ax == 0; }
    __device__ __forceinline__ void prefetch(const Unit&, int, unsigned (&pf)[4]) const { pf[0] = pf[1] = pf[2] = pf[3] = 0u; }
    __device__ __forceinline__ void operator()(PG8_ACC, const Unit& u, int wr, int wc, int fr, int fq) const {
        { int t_ = threadIdx.x; asm volatile("" : "+v"(t_)); fr = t_ & 15; fq = (t_ >> 4) & 3; }
        const int pm = u.ax ? u.pm - 64 : u.pm, pn = u.ax ? u.pn - 8 : u.pn;
        const unsigned loff = (unsigned)(((wr * 64 + fr) * DM + wc * 32 + 8 * fq) * 2);
        const size_t uoff = ((size_t)pm * BM * DM + (size_t)pn * BM) * 2;
        const long long d_sb = (const char*)sb - (const char*)sa;
        const char* gp = (const char*)sa + (u.ax ? d_sb : 0ll) + uoff;
#pragma unroll
        for (int ai = 0; ai < 2; ++ai) {
            u32x4 gv[4][2];
#pragma unroll
            for (int m = 0; m < 4; ++m)
#pragma unroll
                for (int bj = 0; bj < 2; ++bj) gv[m][bj] = *(const u32x4*)(gp + (size_t)(((ai * HALF + m * 16) * DM + bj * HALF) * 2) + loff);
            if (u.ax == 0) {
#pragma unroll
                for (int m = 0; m < 4; ++m)
#pragma unroll
                    for (int bj = 0; bj < 2; ++bj) { const u32x4 g4 = gv[m][bj];
                        const float s[8] = {bflo(g4.x), bfhi(g4.x), bflo(g4.y), bfhi(g4.y), bflo(g4.z), bfhi(g4.z), bflo(g4.w), bfhi(g4.w)};
#pragma unroll
                        for (int j = 0; j < 4; ++j) { acc[ai][bj][m][0][j] *= s[j]; acc[ai][bj][m][1][j] *= s[4 + j]; } }
            } else {
                char* op = (char*)O + uoff;
#pragma unroll
                for (int m = 0; m < 4; ++m)
#pragma unroll
                    for (int bj = 0; bj < 2; ++bj) { const u32x4 g4 = gv[m][bj];
                        const float s[8] = {bflo(g4.x), bfhi(g4.x), bflo(g4.y), bfhi(g4.y), bflo(g4.z), bfhi(g4.z), bflo(g4.w), bfhi(g4.w)};
                        f32x4 v0 = acc[ai][bj][m][0], v1 = acc[ai][bj][m][1];
#pragma unroll
                        for (int j = 0; j < 4; ++j) { v0[j] *= s[j]; v1[j] *= s[4 + j]; }
                        u32x4 w; w.x = cvt_pk_bf16(v0[0], v0[1]); w.y = cvt_pk_bf16(v0[2], v0[3]); w.z = cvt_pk_bf16(v1[0], v1[1]); w.w = cvt_pk_bf16(v1[2], v1[3]);
                        *(u32x4*)(op + (size_t)(((ai * HALF + m * 16) * DM + bj * HALF) * 2) + loff) = w; }
            }
            asm volatile("" ::: "memory");
        }
    }
};
struct EpiY {
    static constexpr bool PERM = true, KEEP = false;
    bf16_t* O;
    __device__ __forceinline__ bool keep(const Unit&) const { return false; }
    __device__ __forceinline__ void prefetch(const Unit&, int, unsigned (&pf)[4]) const { pf[0] = pf[1] = pf[2] = pf[3] = 0u; }
    __device__ __forceinline__ void operator()(PG8_ACC, const Unit& u, int wr, int wc, int fr, int fq) const {
        const int row0 = u.pm * BM + wr * 64 + fr, col0 = u.pn * BM + wc * 32 + 8 * fq;
#pragma unroll
        for (int ai = 0; ai < 2; ++ai)
#pragma unroll
            for (int m = 0; m < 4; ++m) { bf16_t* rowp = O + (size_t)(row0 + ai * HALF + m * 16) * DM + col0;
#pragma unroll
                for (int bj = 0; bj < 2; ++bj) { const f32x4 v0 = acc[ai][bj][m][0], v1 = acc[ai][bj][m][1];
                    u32x4 w; w.x = cvt_pk_bf16(v0[0], v0[1]); w.y = cvt_pk_bf16(v0[2], v0[3]); w.z = cvt_pk_bf16(v1[0], v1[1]); w.w = cvt_pk_bf16(v1[2], v1[3]);
                    *(u32x4*)(rowp + bj * HALF) = w; } }
    }
};
struct EpiGU {
    static constexpr bool PERM = true, KEEP = false;
    unsigned char* hb;
    __device__ __forceinline__ bool keep(const Unit&) const { return false; }
    __device__ __forceinline__ void prefetch(const Unit&, int, unsigned (&pf)[4]) const { pf[0] = pf[1] = pf[2] = pf[3] = 0u; }
    __device__ __forceinline__ void operator()(PG8_ACC, const Unit& u, int wr, int wc, int fr, int fq) const {
        { int t_ = threadIdx.x; asm volatile("" : "+v"(t_)); fr = t_ & 15; fq = (t_ >> 4) & 3; }
        const int row0 = u.pm * BM + wr * 64 + fr, col0 = (u.pn & 3) * HALF + wc * 32 + 8 * fq;
#pragma unroll
        for (int ai = 0; ai < 2; ++ai)
#pragma unroll
            for (int m = 0; m < 4; ++m) { unsigned char* rowp = hb + (size_t)(row0 + ai * HALF + m * 16) * DE + col0;
                f32x4 g0 = acc[ai][0][m][0], g1 = acc[ai][0][m][1]; const f32x4 u0 = acc[ai][1][m][0], u1 = acc[ai][1][m][1];
#pragma unroll
                for (int j = 0; j < 4; ++j) { g0[j] = g0[j] * sigmoidf_(g0[j]) * u0[j]; g1[j] = g1[j] * sigmoidf_(g1[j]) * u1[j]; }
                u32x2 w; w.x = pk4_fp8(g0[0], g0[1], g0[2], g0[3]); w.y = pk4_fp8(g1[0], g1[1], g1[2], g1[3]);
                *(u32x2*)rowp = w; }
    }
};
struct EpiDown {
    static constexpr bool PERM = true, KEEP = false;
    unsigned char* ys;
    __device__ __forceinline__ bool keep(const Unit&) const { return false; }
    __device__ __forceinline__ void prefetch(const Unit&, int, unsigned (&pf)[4]) const { pf[0] = pf[1] = pf[2] = pf[3] = 0u; }
    __device__ __forceinline__ void operator()(PG8_ACC, const Unit& u, int wr, int wc, int fr, int fq) const {
        { int t_ = threadIdx.x; asm volatile("" : "+v"(t_)); fr = t_ & 15; fq = (t_ >> 4) & 3; }
        const int row0 = u.pm * BM + wr * 64 + fr, col0 = (u.pn & 7) * BM + wc * 32 + 8 * fq;
#pragma unroll
        for (int ai = 0; ai < 2; ++ai)
#pragma unroll
            for (int m = 0; m < 4; ++m) { unsigned char* rowp = ys + (size_t)(row0 + ai * HALF + m * 16) * DM + col0;
#pragma unroll
                for (int bj = 0; bj < 2; ++bj) { const f32x4 v0 = acc[ai][bj][m][0], v1 = acc[ai][bj][m][1];
                    u32x2 w; w.x = pk4_fp8(v0[0], v0[1], v0[2], v0[3]); w.y = pk4_fp8(v1[0], v1[1], v1[2], v1[3]);
                    *(u32x2*)(rowp + bj * HALF) = w; } }
    }
};

typedef int v8i32 __attribute__((ext_vector_type(8)));
template <class Epi, class Sched, bool ALIGN_EPI, bool FP8 = false>
__device__ __forceinline__ void gemm_phase(LAS unsigned char* lds, const Gemm g, const Sched& S, const Epi& E) {
    const int tid = threadIdx.x, wid = __builtin_amdgcn_readfirstlane(tid >> 6), lane = tid & 63, wr = wid >> 2, wc = wid & 3, fr = lane & 15, fq = lane >> 4;
    const int K = g.K, nt = K / BK;
    unsigned voffA[2], voffB[2]; int stR[2], stC[2];
#pragma unroll
    for (int i = 0; i < 2; ++i) { int R, C; stage_rc(tid * 16 + i * 8192, R, C); const int Rb = Epi::PERM ? ((R & ~31) + perm32(R & 31)) : R;
        stR[i] = R; stC[i] = C; voffA[i] = (unsigned)(R * K + C) * 2u; voffB[i] = (unsigned)(Rb * K + C) * 2u; }
    const size_t kstep = (size_t)(BK * 2);
    const size_t hstep = (size_t)HALF * K * 2;
    const size_t tstep = 2 * hstep;
    const unsigned ldsw = (unsigned)wid * 1024u;
    const int aoff = FP8 ? lds_byte(wr * 64 + fr, fq * 16) : lds_byte(wr * 64 + fr, fq * 8), boff = FP8 ? lds_byte(wc * 32 + fr, fq * 16) : lds_byte(wc * 32 + fr, fq * 8);
#define PG8_SA(b, h) (((b) * 2 + (h)) * HTB)
#define PG8_SB(b, h) ((4 + (b) * 2 + (h)) * HTB)
#define PG8_STAGE(bufoff, gbase, voff) do { _Pragma("unroll") for (int _i = 0; _i < 2; ++_i) \
        __builtin_amdgcn_global_load_lds((const unsigned*)((const char*)(gbase) + (voff)[_i]), (LAS unsigned*)(lds + (bufoff) + ldsw + _i * 8192), 16, 0, 0); } while (0)
#define PG8_STAGE_A(bufoff, ubase, vg, h, kb) do { if constexpr (Sched::GATHER) PG8_STAGE(bufoff, (const char*)g.A + (kb), (vg)[h]); else PG8_STAGE(bufoff, (ubase) + (h) * hstep + (kb), voffA); } while (0)
#define PG8_LD16(off) (*(const LAS bf16x8*)(lds + (off)))
#define PG8_CAT8(lo, hi) __builtin_bit_cast(v8i32, __builtin_shufflevector((lo), (hi), 0, 1, 2, 3, 4, 5, 6, 7, 8, 9, 10, 11, 12, 13, 14, 15))
#define PG8_LDA(dst, b, h) do { if constexpr (FP8) { int ab_ = aoff; asm volatile("" : "+v"(ab_)); ab_ += PG8_SA(b, h);   \
            _Pragma("unroll") for (int m = 0; m < 4; ++m) dst##8[m] = PG8_CAT8(PG8_LD16(ab_ + m * 2048), PG8_LD16(ab_ + m * 2048 + 16)); } \
        else { _Pragma("unroll") for (int m = 0; m < 4; ++m) _Pragma("unroll") for (int k = 0; k < 2; ++k) dst[m][k] = PG8_LD16(PG8_SA(b, h) + aoff + m * 2048 + k * 1024); } } while (0)
#define PG8_LDB(dst, b, h) do { if constexpr (FP8) { int bb_ = boff; asm volatile("" : "+v"(bb_)); bb_ += PG8_SB(b, h); \
            _Pragma("unroll") for (int n = 0; n < 2; ++n) dst##8[n] = PG8_CAT8(PG8_LD16(bb_ + n * 2048), PG8_LD16(bb_ + n * 2048 + 16)); } \
        else { _Pragma("unroll") for (int n = 0; n < 2; ++n) _Pragma("unroll") for (int k = 0; k < 2; ++k) dst[n][k] = PG8_LD16(PG8_SB(b, h) + boff + n * 2048 + k * 1024); } } while (0)
#define PG8_MMA(ai, bj, At, Bt) do { __builtin_amdgcn_s_setprio(1); \
        if constexpr (FP8) { _Pragma("unroll") for (int m = 0; m < 4; ++m) _Pragma("unroll") for (int n = 0; n < 2; ++n) \
            acc[ai][bj][m][n] = __builtin_amdgcn_mfma_scale_f32_16x16x128_f8f6f4(Bt##8[n], At##8[m], acc[ai][bj][m][n], 0, 0, 0, 0x79797979, 0, 0x7f7f7f7f); } \
        else { _Pragma("unroll") for (int m = 0; m < 4; ++m) _Pragma("unroll") for (int n = 0; n < 2; ++n) _Pragma("unroll") for (int k = 0; k < 2; ++k) \
            acc[ai][bj][m][n] = __builtin_amdgcn_mfma_f32_16x16x32_bf16(Bt[n][k], At[m][k], acc[ai][bj][m][n], 0, 0, 0); } \
        __builtin_amdgcn_s_setprio(0); \
        if constexpr (FP8) asm volatile("" : "+v"(acc[ai][bj][0][0]), "+v"(acc[ai][bj][0][1]), "+v"(acc[ai][bj][1][0]), "+v"(acc[ai][bj][1][1]), "+v"(acc[ai][bj][2][0]), "+v"(acc[ai][bj][2][1]), "+v"(acc[ai][bj][3][0]), "+v"(acc[ai][bj][3][1])); \
        } while (0)
#define PG8_WAIT_V(n) asm volatile("s_waitcnt vmcnt(" #n ")" ::: "memory")
#define PG8_WAIT_L(n) asm volatile("s_waitcnt lgkmcnt(" #n ")" ::: "memory")
#define PG8_BAR __builtin_amdgcn_s_barrier()
#define PG8_SCHED __builtin_amdgcn_sched_barrier(0)
#define PG8_PIN do { } while (0)
#define PG8_UNI(u) do { (u).pm = __builtin_amdgcn_readfirstlane((u).pm); (u).pn = __builtin_amdgcn_readfirstlane((u).pn); (u).ax = __builtin_amdgcn_readfirstlane((u).ax); (u).ax2 = __builtin_amdgcn_readfirstlane((u).ax2); } while (0)
#define PG8_FILL(v, u) do { _Pragma("unroll") for (int _h = 0; _h < 2; ++_h) _Pragma("unroll") for (int _i = 0; _i < 2; ++_i) \
        (v)[_h][_i] = (unsigned)(S.row_src((u), _h * HALF + stR[_i]) * K + stC[_i]) * 2u; } while (0)
    Unit cur, nxt; int ui = 0;
    if (!S.next(0, cur)) return;
    PG8_UNI(cur);
    f32x4 acc[2][2][4][2];
#pragma unroll
    for (int a = 0; a < 2; ++a)
#pragma unroll
        for (int b = 0; b < 2; ++b)
#pragma unroll
            for (int m = 0; m < 4; ++m)
#pragma unroll
                for (int n = 0; n < 2; ++n) acc[a][b][m][n] = (f32x4){0.f, 0.f, 0.f, 0.f};
    bf16x8 At[4][2], B0[2][2], B1[2][2];
    v8i32 At8[4], B08[2], B18[2];
    unsigned vAc[2][2] = {{0u, 0u}, {0u, 0u}}, vAn[2][2] = {{0u, 0u}, {0u, 0u}}, vA2[2][2] = {{0u, 0u}, {0u, 0u}};
    if constexpr (Sched::GATHER) PG8_FILL(vAc, cur);
    const char* cA = (const char*)g.A + (Sched::GATHER ? (size_t)0 : (size_t)cur.pm * tstep); const char* cB = (const char*)g.Bt + (size_t)cur.pn * tstep;
    PG8_STAGE(PG8_SB(0, 0), cB, voffB); PG8_STAGE(PG8_SB(0, 1), cB + hstep, voffB); PG8_STAGE_A(PG8_SA(0, 0), cA, vAc, 0, (size_t)0); PG8_STAGE_A(PG8_SA(0, 1), cA, vAc, 1, (size_t)0);
    if (wr == 1) PG8_BAR;
    PG8_WAIT_V(2); PG8_BAR;
    PG8_STAGE(PG8_SB(1, 0), cB + kstep, voffB); PG8_STAGE_A(PG8_SA(1, 0), cA, vAc, 0, kstep); PG8_STAGE(PG8_SB(1, 1), cB + hstep + kstep, voffB);
    PG8_WAIT_V(6); PG8_BAR;
    GP_ACC(29);
    for (;;) {
        bool has_next = S.next(ui + 1, nxt);
        has_next = __builtin_amdgcn_readfirstlane((int)has_next) != 0;
        if (has_next) { PG8_UNI(nxt); if constexpr (Sched::GATHER) PG8_FILL(vAn, nxt); }
        const char* nA = (has_next && !Sched::GATHER) ? (const char*)g.A + (size_t)nxt.pm * tstep : cA; const char* nB = has_next ? (const char*)g.Bt + (size_t)nxt.pn * tstep : cB;
        for (int t = 0; t < nt; t += 2) {
            if constexpr (FP8) asm volatile("" : "+v"(voffA[0]), "+v"(voffA[1]), "+v"(voffB[0]), "+v"(voffB[1]));
            const bool last = (t == nt - 2);
            const size_t k1 = (size_t)(t + 1) * kstep;
            const size_t k2 = last ? (size_t)0 : (size_t)(t + 2) * kstep, k3 = k2 + kstep;
            const char* a2 = last ? nA : cA; const char* b2 = (last ? nB : cB) + k2; const char* b3 = b2 + kstep;
            if constexpr (Sched::GATHER) {
#pragma unroll
                for (int h = 0; h < 2; ++h)
#pragma unroll
                    for (int i = 0; i < 2; ++i) vA2[h][i] = (last && has_next) ? vAn[h][i] : vAc[h][i];
            }
            PG8_LDB(B0, 0, 0); PG8_LDB(B1, 0, 1); PG8_SCHED; PG8_LDA(At, 0, 0); PG8_STAGE_A(PG8_SA(1, 1), cA, vAc, 1, k1);
            PG8_WAIT_V(8); PG8_WAIT_L(0); PG8_BAR; PG8_PIN; PG8_MMA(0, 0, At, B0); PG8_MMA(0, 1, At, B1); PG8_PIN; PG8_BAR; PG8_SCHED;
            PG8_LDA(At, 0, 1); PG8_STAGE(PG8_SB(0, 0), b2, voffB); PG8_STAGE(PG8_SB(0, 1), b2 + hstep, voffB); PG8_STAGE_A(PG8_SA(0, 0), a2, vA2, 0, k2);
            PG8_WAIT_V(8); PG8_WAIT_L(0); PG8_BAR; PG8_PIN; PG8_MMA(1, 0, At, B0); PG8_MMA(1, 1, At, B1); PG8_PIN; PG8_BAR; PG8_SCHED;
            PG8_LDB(B0, 1, 0); PG8_LDB(B1, 1, 1); PG8_SCHED; PG8_LDA(At, 1, 0); PG8_STAGE_A(PG8_SA(0, 1), a2, vA2, 1, k2);
            PG8_WAIT_V(8); PG8_WAIT_L(0); PG8_BAR; PG8_PIN; PG8_MMA(0, 0, At, B0); PG8_MMA(0, 1, At, B1); PG8_PIN; PG8_BAR; PG8_SCHED;
            PG8_LDA(At, 1, 1); PG8_STAGE(PG8_SB(1, 0), b3, voffB); PG8_STAGE(PG8_SB(1, 1), b3 + hstep, voffB); PG8_STAGE_A(PG8_SA(1, 0), a2, vA2, 0, k3);
            PG8_WAIT_V(8); PG8_WAIT_L(0); PG8_BAR; PG8_PIN; PG8_MMA(1, 0, At, B0); PG8_MMA(1, 1, At, B1); PG8_PIN; PG8_BAR; PG8_SCHED;
        }
        GP_ACC(26);
        if constexpr (ALIGN_EPI) { if (wr == 0) PG8_BAR; }
        E(acc, cur, wr, wc, fr, fq);
        GP_ACC(27);
        if constexpr (GP_PROBE && __is_same(Epi, GP_PROBE_EPI)) { if (tid == 0) ((volatile LAS unsigned long long*)(lds + 131072 + 1024))[28] += 100ull; }
        if (!has_next) break;
        if (!(Epi::KEEP && E.keep(cur))) {
#pragma unroll
            for (int a = 0; a < 2; ++a)
#pragma unroll
                for (int b = 0; b < 2; ++b)
#pragma unroll
                    for (int m = 0; m < 4; ++m)
#pragma unroll
                        for (int n = 0; n < 2; ++n) acc[a][b][m][n] = (f32x4){0.f, 0.f, 0.f, 0.f};
        }
        cur = nxt; cA = nA; cB = nB; ++ui;
        if constexpr (Sched::GATHER) {
#pragma unroll
            for (int h = 0; h < 2; ++h)
#pragma unroll
                for (int i = 0; i < 2; ++i) vAc[h][i] = vAn[h][i];
        }
        if constexpr (ALIGN_EPI) { if (wr == 1) PG8_BAR; }
    }
    PG8_WAIT_V(0);
    if constexpr (!ALIGN_EPI) { if (wr == 0) PG8_BAR; }
    PG8_BAR;
#undef PG8_SA
#undef PG8_SB
#undef PG8_STAGE
#undef PG8_STAGE_A
#undef PG8_LDA
#undef PG8_LDB
#undef PG8_MMA
#undef PG8_CAT8
#undef PG8_LD16
#undef PG8_WAIT_V
#undef PG8_WAIT_L
#undef PG8_BAR
#undef PG8_SCHED
#undef PG8_PIN
#undef PG8_UNI
#undef PG8_FILL
}
}

#define XB_TMO      128
#define XB_XCNT(j)  (256  + 64 * (j))
#define XB_XSUB(j)  (1280 + 64 * (j))
#define XB_XGEN(j)  (2304 + 64 * (j))
#define XB_TOP      3328
#define XB_TOPGEN   3392
#define XCD_BAR_WORDS 3456
#define XB_SPIN_CAP (1u << 18)
__device__ __forceinline__ unsigned xb_ld(unsigned* p)              { return __hip_atomic_load(p, __ATOMIC_RELAXED, __HIP_MEMORY_SCOPE_AGENT); }
__device__ __forceinline__ unsigned xb_add(unsigned* p, unsigned v) { return __hip_atomic_fetch_add(p, v, __ATOMIC_RELAXED, __HIP_MEMORY_SCOPE_AGENT); }
__device__ __forceinline__ unsigned xb_xcc_id() { return (unsigned)__builtin_amdgcn_s_getreg((3 << 11) | 20) & 0xFu; }
#define XB_SPIN(cond, bar) do { unsigned _sp = 0; while (cond) { __builtin_amdgcn_s_sleep(1); \
    if ((++_sp & 255u) == 0u) { if (xb_ld(&(bar)[XB_TMO])) break; if (_sp > XB_SPIN_CAP) { atomicAdd(&(bar)[XB_TMO], 1u); break; } } } } while (0)
struct XcdBarrier { unsigned* bar; unsigned x; volatile LAS unsigned* st; };
__device__ __forceinline__ XcdBarrier xcd_barrier_post(unsigned* bar, volatile LAS unsigned* st) {
    XcdBarrier b; b.bar = bar; b.x = xb_xcc_id(); b.st = st;
    if (threadIdx.x == 0) (void)xb_add(&bar[XB_XCNT(b.x)], 1u);
    return b;
}
__device__ __forceinline__ void xcd_barrier_complete(unsigned* bar, unsigned x, unsigned& nloc, unsigned& nx) {
    const unsigned G = gridDim.x * gridDim.y * gridDim.z;
    unsigned sum, cnt, mine, sp = 0u;
    for (;;) {
        sum = 0u; cnt = 0u; mine = 0u;
#pragma unroll
        for (unsigned j = 0; j < 16; ++j) { const unsigned c = xb_ld(&bar[XB_XCNT(j)]); sum += c; cnt += (c > 0u) ? 1u : 0u; mine = (j == x) ? c : mine; }
        if (sum == G) break;
        __builtin_amdgcn_s_sleep(1);
        if ((++sp & 255u) == 0u) { if (xb_ld(&bar[XB_TMO])) break; if (sp > XB_SPIN_CAP) { atomicAdd(&bar[XB_TMO], 1u); break; } }
    }
    nloc = mine > 0u ? mine : 1u; nx = cnt > 0u ? cnt : 1u;
}
__device__ __forceinline__ void xcd_barrier(const XcdBarrier& b) {
    asm volatile("s_waitcnt vmcnt(0)" ::: "memory");
    __syncthreads();
    if (threadIdx.x == 0) {
        unsigned* bar = b.bar;
        __builtin_amdgcn_s_waitcnt(0);
        unsigned nloc = b.st[0], nx = b.st[1];
        if (nloc == 0u) { xcd_barrier_complete(bar, b.x, nloc, nx); b.st[0] = nloc; b.st[1] = nx; }
        const unsigned old = xb_add(&bar[XB_XSUB(b.x)], 1u);
        const unsigned gen = old / nloc;
        if (old + 1u == (gen + 1u) * nloc) {
            __builtin_amdgcn_fence(__ATOMIC_RELEASE, "agent");
            asm volatile("s_waitcnt vmcnt(0)" ::: "memory");
            const unsigned og = xb_add(&bar[XB_TOP], 1u);
            const unsigned tg = og / nx;
            if (og + 1u == (tg + 1u) * nx) xb_add(&bar[XB_TOPGEN], 1u);
            else XB_SPIN(xb_ld(&bar[XB_TOPGEN]) == tg, bar);
            __builtin_amdgcn_fence(__ATOMIC_ACQUIRE, "agent");
            xb_add(&bar[XB_XGEN(b.x)], 1u);
            asm volatile("s_waitcnt vmcnt(0)" ::: "memory");
        } else {
            XB_SPIN(xb_ld(&bar[XB_XGEN(b.x)]) == gen, bar);
            __builtin_amdgcn_fence(__ATOMIC_ACQUIRE, "agent");
            asm volatile("s_waitcnt vmcnt(0)" ::: "memory");
        }
    }
    __syncthreads();
}

__device__ __forceinline__ void transpose_item(const float* W, int K, int N, bf16_t* WT, int k0, int n0, int dst_off, LAS float* scr, int lane) {
    float tv[32];
#pragma unroll
    for (int i = 0; i < 32; ++i) { const int kk = 2 * i + (lane >> 5); tv[i] = __builtin_nontemporal_load(&W[(size_t)(k0 + kk) * N + n0 + (lane & 31)]); }
#pragma unroll
    for (int i = 0; i < 32; ++i) { const int kk = 2 * i + (lane >> 5); scr[kk * 33 + (lane & 31)] = tv[i]; }
    LDS_WAIT(); asm volatile("" ::: "memory");
    const int c = lane & 7;
#pragma unroll
    for (int j = 0; j < 4; ++j) { const int n = (lane >> 3) + 8 * j; const LAS float* s = scr + (8 * c) * 33 + n;
        u32x4 o; o.x = pk2(s[0 * 33], s[1 * 33]); o.y = pk2(s[2 * 33], s[3 * 33]); o.z = pk2(s[4 * 33], s[5 * 33]); o.w = pk2(s[6 * 33], s[7 * 33]);
        *(u32x4*)(WT + (size_t)(dst_off + n0 + n) * K + k0 + 8 * c) = o; }
    LDS_WAIT(); asm volatile("" ::: "memory");
}
__device__ __forceinline__ void transpose_item_fp8(const float* W, int K, int N, unsigned char* WT, int k0, int n0, int dst_off, LAS float* scr, int lane) {
    float tv[32];
#pragma unroll
    for (int i = 0; i < 32; ++i) { const int kk = 2 * i + (lane >> 5); tv[i] = __builtin_nontemporal_load(&W[(size_t)(k0 + kk) * N + n0 + (lane & 31)]); }
#pragma unroll
    for (int i = 0; i < 32; ++i) { const int kk = 2 * i + (lane >> 5); scr[kk * 33 + (lane & 31)] = tv[i]; }
    LDS_WAIT(); asm volatile("" ::: "memory");
    const int c = lane & 7;
#pragma unroll
    for (int j = 0; j < 4; ++j) { const int n = (lane >> 3) + 8 * j; const LAS float* s = scr + (8 * c) * 33 + n;
        u32x2 o; o.x = pk4_fp8(s[0 * 33] * 64.f, s[1 * 33] * 64.f, s[2 * 33] * 64.f, s[3 * 33] * 64.f); o.y = pk4_fp8(s[4 * 33] * 64.f, s[5 * 33] * 64.f, s[6 * 33] * 64.f, s[7 * 33] * 64.f);
        *(u32x2*)(WT + (size_t)(dst_off + n0 + n) * K + k0 + 8 * c) = o; }
    LDS_WAIT(); asm volatile("" ::: "memory");
}
__device__ __forceinline__ bool win_is_bf16(int n0) { return n0 < 2048; }
__device__ __forceinline__ int win_dst(int n0) { return n0; }
__device__ __forceinline__ int win8_dst(int n0) {
    if (n0 < 3072) return 5120 + (n0 - 2048);
    if (n0 < 4096) return 4096 + (n0 - 3072);
    if (n0 < 5120) return 6144 + (n0 - 4096);
    const int g = n0 - 5120, c = g & 2047;
    return 256 * (c >> 7) + (c & 127) + (g >= 2048 ? 128 : 0);
}

#ifndef DBG_COUNT
#define DBG_COUNT 0
#endif
__device__ __forceinline__ int crow(int r, int hi) { return (r & 3) + 8 * (r >> 2) + 4 * hi; }
__device__ __forceinline__ int kperm(int i) { return (i & 0x13) | ((i & 8) >> 1) | ((i & 4) << 1); }
__device__ __forceinline__ void sb_dma_k(const bf16_t* Kb, size_t tokrow0, int h, LAS unsigned char* kt, int lane) {
    const int rsub = lane >> 4, p = lane & 15;
#pragma unroll
    for (int i = 0; i < 8; ++i) { const int row = 4 * i + rsub, c = p ^ (row & 15);
        __builtin_amdgcn_global_load_lds((const unsigned*)(Kb + (tokrow0 + row) * SBW + h * HD + c * 8), (LAS unsigned*)(kt + i * 1024), 16, 0, 0); }
}
__device__ __forceinline__ void sb_dma_v(const bf16_t* VT, size_t tokcol0, int h, LAS unsigned char* vt, int lane) {
    const int dsub = lane >> 2, p = lane & 3;
#pragma unroll
    for (int i = 0; i < 8; ++i) { const int d = 16 * i + dsub, c = p ^ ((d >> 2) & 3);
        __builtin_amdgcn_global_load_lds((const unsigned*)(VT + (size_t)(h * HD + d) * VTP + tokcol0 + c * 8), (LAS unsigned*)(vt + i * 1024), 16, 0, 0); }
}
__device__ __forceinline__ void sb_attn_unit(int b, int h, int qb, const bf16_t* Q, const bf16_t* Kb, const bf16_t* VT, bf16_t* Oa, LAS unsigned char* wsl  , int lane, unsigned* dbg_cnt) {
    const int r32 = lane & 31, hi = lane >> 5;
    const size_t tok0 = (size_t)b * SEQ;
    LAS unsigned char* kt = wsl; LAS unsigned char* vt = wsl + 8192;
    asm volatile("s_waitcnt vmcnt(0)" ::: "memory");
    sb_dma_k(Kb, tok0 + (size_t)qb * 32, h, kt, lane);
    sb_dma_v(VT, tok0 + (size_t)qb * 32, h, vt, lane);
    bf16x8 qf[8];
    { const bf16_t* qp = Q + (tok0 + (size_t)qb * 32 + r32) * SBW + h * HD + 8 * hi;
#pragma unroll
      for (int st = 0; st < 8; ++st) qf[st] = *(const bf16x8*)(qp + 16 * st); }
    asm volatile("s_waitcnt vmcnt(0)" ::: "memory");
    f32x16 o[4];
#pragma unroll
    for (int d = 0; d < 4; ++d)
#pragma unroll
        for (int r = 0; r < 16; ++r) o[d][r] = 0.f;
    float carry = 0.f;
    const int krow = kperm(r32);
    const LAS unsigned char* kfp = kt + krow * 256;
    const int kx = krow & 15;
    bool first = true;
    for (int kb = qb; kb >= 0; --kb) {
        const int kn = kb > 0 ? kb - 1 : 0;
        int hio = hi; asm volatile("" : "+v"(hio));
        if (!first) asm volatile("s_waitcnt vmcnt(8)" ::: "memory");
        f32x16 sc;
#pragma unroll
        for (int r = 0; r < 16; ++r) sc[r] = 0.f;
        bf16x8 kf[8];
#pragma unroll
        for (int st = 0; st < 8; ++st) kf[st] = *(const LAS bf16x8*)(kfp + (((2 * st + hio) ^ kx) << 4));
        asm volatile("s_waitcnt lgkmcnt(0)" ::: "memory");
        sb_dma_k(Kb, tok0 + (size_t)kn * 32, h, kt, lane);
#pragma unroll
        for (int st = 0; st < 8; ++st) sc = __builtin_amdgcn_mfma_f32_32x32x16_bf16(kf[st], qf[st], sc, 0, 0, 0);
        const bool diag = (kb == qb);
        float L[16];
#pragma unroll
        for (int r = 0; r < 16; ++r) {
            const float z = sc[r];
            const float sp = fmaxf(z, 0.f) + __builtin_amdgcn_logf(1.0f + __builtin_amdgcn_exp2f(-fabsf(z)));
            const bool valid = !diag || (16 * (r >> 3) + 8 * hi + (r & 7) < r32);
            L[r] = valid ? -sp : 0.f;
        }
#pragma unroll
        for (int s2 = 0; s2 < 2; ++s2)
#pragma unroll
            for (int j = 6; j >= 0; --j) L[8 * s2 + j] += L[8 * s2 + j + 1];
        const float g0 = L[0], g1 = L[8];
        const float p0 = xor32_get(g0, hi), p1 = xor32_get(g1, hi);
        const float t1 = g1 + p1, t0 = g0 + p0;
        const float aft1 = (hi == 0 ? p1 : 0.f) + carry, aft0 = t1 + (hi == 0 ? p0 : 0.f) + carry;
        f32x16 p;
#pragma unroll
        for (int r = 0; r < 16; ++r) { const bool valid = !diag || (16 * (r >> 3) + 8 * hi + (r & 7) < r32);
            p[r] = valid ? __builtin_amdgcn_exp2f(sc[r] + L[r] + (r < 8 ? aft0 : aft1)) : 0.f; }
        carry += t0 + t1;
        asm volatile("s_waitcnt vmcnt(8)" ::: "memory");
#pragma unroll
        for (int s2 = 0; s2 < 2; ++s2) {
            u32x4 pp; pp.x = pk2(p[8 * s2], p[8 * s2 + 1]); pp.y = pk2(p[8 * s2 + 2], p[8 * s2 + 3]); pp.z = pk2(p[8 * s2 + 4], p[8 * s2 + 5]); pp.w = pk2(p[8 * s2 + 6], p[8 * s2 + 7]);
            const bf16x8 pf = __builtin_bit_cast(bf16x8, pp);
#pragma unroll
            for (int d = 0; d < 4; ++d) { const int dd = d * 32 + r32;
                const bf16x8 vf = *(const LAS bf16x8*)(vt + dd * 64 + (((2 * s2 + hio) ^ ((dd >> 2) & 3)) << 4));
                o[d] = __builtin_amdgcn_mfma_f32_32x32x16_bf16(pf, vf, o[d], 0, 0, 0); }
        }
        if (DBG_COUNT == 1 && lane == 0) atomicAdd(dbg_cnt, 1u);
        if (__builtin_amdgcn_ballot_w64(carry >= -44.0f) == 0ull) break;
        asm volatile("s_waitcnt lgkmcnt(0)" ::: "memory");
        sb_dma_v(VT, tok0 + (size_t)kn * 32, h, vt, lane);
        first = false;
    }
    asm volatile("s_waitcnt vmcnt(0)" ::: "memory");
    bf16_t* op = Oa + (tok0 + (size_t)qb * 32) * SBW + h * HD + r32;
#pragma unroll
    for (int d = 0; d < 4; ++d)
#pragma unroll
        for (int r = 0; r < 16; ++r) op[(size_t)crow(r, hi) * SBW + d * 32] = (bf16_t)f2bf(o[d][r]);
}

#ifndef SGU_PROBE
#define SGU_PROBE 0
#endif
#define SGU_ACC(slot) do { if (SGU_PROBE && tid == 0) { volatile LAS unsigned long long* t_ = (volatile LAS unsigned long long*)(lds + 131072 + 1024); const unsigned long long n_ = __builtin_amdgcn_s_memrealtime(); t_[slot] += n_ - t_[18]; t_[18] = n_; } } while (0)
template <int NKS>
__device__ __forceinline__ void sgu_mma(int g, int t0, size_t m0, const LAS unsigned char* yt, const bf16_t* SU, const float* sgu_w, const float* sgu_b, const float* lng, const float* lnb, bf16_t* Ob,
                                        const LAS float* mu, const LAS float* rs, LAS float* c1s, LAS float* c2s, const LAS float* sbl  , int r32, int hi) {
    asm volatile("" : "+v"(r32), "+v"(hi));
    f32x16 acc[4];
#pragma unroll
    for (int d = 0; d < 4; ++d)
#pragma unroll
        for (int r = 0; r < 16; ++r) acc[d][r] = 0.f;
    float c1 = 0.f, c2 = 0.f;
    unsigned uu[4][16]; float gn[4], bs[4];
    { const bf16_t* sup = SU + (m0 + t0) * SGW + g * 128 + r32;
#pragma unroll
      for (int r = 0; r < 16; ++r) { const int tl = crow(r, hi);
#pragma unroll
          for (int d = 0; d < 4; ++d) uu[d][r] = sup[(size_t)tl * SGW + d * 32]; }
#pragma unroll
      for (int d = 0; d < 4; ++d) { gn[d] = lng[g * 128 + d * 32 + r32]; bs[d] = lnb[g * 128 + d * 32 + r32]; } }
    const float* wrow = sgu_w + ((size_t)g * 128 + t0 + r32) * 128 + 8 * hi;
#pragma unroll
    for (int kq = 0; kq < NKS / 4; ++kq) {
    f32x4 w0[4], w1[4];
#pragma unroll
    for (int kk = 0; kk < 4; ++kk) { w0[kk] = *(const f32x4*)(wrow + 16 * (4 * kq + kk)); w1[kk] = *(const f32x4*)(wrow + 16 * (4 * kq + kk) + 4); }
#pragma unroll
    for (int kk = 0; kk < 4; ++kk) {
        const int ks = 4 * kq + kk;
        const int k0 = 16 * ks + 8 * hi;
        const f32x4 r0 = *(const LAS f32x4*)(rs + k0), r1 = *(const LAS f32x4*)(rs + k0 + 4), u0 = *(const LAS f32x4*)(mu + k0), u1 = *(const LAS f32x4*)(mu + k0 + 4);
        const f32x4 p0 = w0[kk] * r0, p1 = w1[kk] * r1;
        c1 += (p0[0] * u0[0] + p0[1] * u0[1]) + (p0[2] * u0[2] + p0[3] * u0[3]) + (p1[0] * u1[0] + p1[1] * u1[1]) + (p1[2] * u1[2] + p1[3] * u1[3]);
        c2 += (w0[kk][0] + w0[kk][1]) + (w0[kk][2] + w0[kk][3]) + (w1[kk][0] + w1[kk][1]) + (w1[kk][2] + w1[kk][3]);
        u32x4 ap; ap.x = pk2(p0[0], p0[1]); ap.y = pk2(p0[2], p0[3]); ap.z = pk2(p1[0], p1[1]); ap.w = pk2(p1[2], p1[3]);
        const bf16x8 af = __builtin_bit_cast(bf16x8, ap);
#pragma unroll
        for (int d = 0; d < 4; ++d) { const int dd = d * 32 + r32;
            const bf16x8 bfr = *(const LAS bf16x8*)(yt + dd * 256 + (((2 * ks + hi) ^ (dd & 15)) << 4));
            acc[d] = __builtin_amdgcn_mfma_f32_32x32x16_bf16(af, bfr, acc[d], 0, 0, 0); }
    }
    asm volatile("" ::: "memory"); }
    c1 = xor32_sum(c1); c2 = xor32_sum(c2);
    if (hi == 0) { c1s[r32] = c1; c2s[r32] = c2; }
    LDS_WAIT(); asm volatile("" ::: "memory");
    { bf16_t* obp = Ob + (m0 + t0) * SGW + g * 128 + r32;
#pragma unroll
      for (int r = 0; r < 16; ++r) { const int tl = crow(r, hi); const float k1 = c1s[tl], k2 = c2s[tl], k3 = sbl[tl];
#pragma unroll
          for (int d = 0; d < 4; ++d) { const float mixed = gn[d] * (acc[d][r] - k1) + bs[d] * k2 + k3;
              obp[(size_t)tl * SGW + d * 32] = (bf16_t)f2bf(__uint_as_float(uu[d][r] << 16) * mixed); } } }
    LDS_WAIT(); asm volatile("" ::: "memory");
}
__device__ __forceinline__ void sgu_item(int blk, int half, const bf16_t* SVT  , const bf16_t* SU, const float* sgu_w, const float* sgu_b,
                                         const float* lng, const float* lnb, bf16_t* Ob, LAS unsigned char* lds, int tid) {
    const int lane = tid & 63, wave = __builtin_amdgcn_readfirstlane(tid >> 6), r32 = lane & 31, hi = lane >> 5;
    const size_t m0 = (size_t)blk * 128;
    LAS unsigned char* yt = lds;
    LAS float* part = (LAS float*)(lds + RING_BYTES + 2048);
    LAS float* mu = part + 2048;
    LAS float* rs = mu + 128;
    LAS float* cw = rs + 128;
    LAS float* sbw = cw + 512 + wave * 64;
    __syncthreads();
    sbw[lane] = sgu_b[(half * 4 + (wave >> 1)) * 128 + (wave & 1) * 64 + lane];
    if (SGU_PROBE && tid == 0) ((volatile LAS unsigned long long*)(lds + 131072 + 1024))[18] = __builtin_amdgcn_s_memrealtime();
    { int lane_o = lane; asm volatile("" : "+v"(lane_o));
      const int gi = wave >> 1, rb = 64 * (wave & 1), rsub = lane_o >> 4, p = lane_o & 15;
      const bf16_t* srow = SVT + (size_t)(half * 512 + gi * 128 + rb + rsub) * VTP + m0;
#pragma unroll
      for (int i = 0; i < 16; ++i) { const int c = p ^ ((4 * i + rsub) & 15);
          __builtin_amdgcn_global_load_lds((const unsigned*)(srow + c * 8), (LAS unsigned*)(yt + gi * 32768 + (rb + 4 * i) * 256), 16, 0, 0);
          srow += 4 * VTP; asm volatile("" : "+v"(srow)); } }
    unsigned pf[2];
    { const int l0 = tid, l1 = tid + 512;
      pf[0] = *(const unsigned*)(SU + (m0 + (l0 >> 3)) * SGW + half * 512 + (l0 & 7) * 64); pf[1] = *(const unsigned*)(SU + (m0 + (l1 >> 3)) * SGW + half * 512 + (l1 & 7) * 64); }
    { float sm[8], sq[8];
#pragma unroll
      for (int t = 0; t < 8; ++t) { sm[t] = 0.f; sq[t] = 0.f; }
      const int rsub = lane >> 4, ch16 = lane & 15;
      const bf16_t* src = SVT + (size_t)(wave * 128 + rsub) * VTP + m0 + 8 * ch16;
#pragma unroll
      for (int hb = 0; hb < 2; ++hb) {
      u32x4 u[16];
#pragma unroll
      for (int i = 0; i < 16; ++i) u[i] = *(const u32x4*)(src + (size_t)(4 * (16 * hb + i)) * VTP);
#pragma unroll
      for (int i = 0; i < 16; ++i) {
          const float x[8] = {bflo(u[i].x), bfhi(u[i].x), bflo(u[i].y), bfhi(u[i].y), bflo(u[i].z), bfhi(u[i].z), bflo(u[i].w), bfhi(u[i].w)};
#pragma unroll
          for (int t = 0; t < 8; ++t) { sm[t] += x[t]; sq[t] += x[t] * x[t]; } }
      asm volatile("" ::: "memory"); }
#pragma unroll
      for (int t = 0; t < 8; ++t) { sm[t] = xor32_sum(xor16_sum(sm[t])); sq[t] = xor32_sum(xor16_sum(sq[t])); }
      if (lane < 16) {
#pragma unroll
          for (int t = 0; t < 8; ++t) { part[(wave * 128 + 8 * ch16 + t) * 2] = sm[t]; part[(wave * 128 + 8 * ch16 + t) * 2 + 1] = sq[t]; } } }
    SGU_ACC(30);
    __syncthreads();
    SGU_ACC(31);
    if (tid < 128) { float s = 0.f, q = 0.f;
#pragma unroll
        for (int w = 0; w < 8; ++w) { s += part[(w * 128 + tid) * 2]; q += part[(w * 128 + tid) * 2 + 1]; }
        const float mean = s * (1.0f / 1024.0f); const float var = fmaxf(q * (1.0f / 1024.0f) - mean * mean, 0.f);
        mu[tid] = mean; rs[tid] = 1.0f / sqrtf(var + LN_EPS); }
    __syncthreads();
    const int g = half * 4 + (wave >> 1), th = wave & 1;
    LAS float* c1s = cw + wave * 64; LAS float* c2s = c1s + 32;
    const LAS unsigned char* ytg = yt + (wave >> 1) * 32768;
    SGU_ACC(32);
    for (int tb = 0; tb < 2; ++tb) {
        const int t0 = th * 64 + tb * 32;
        if (th) sgu_mma<8>(g, t0, m0, ytg, SU, sgu_w, sgu_b, lng, lnb, Ob, mu, rs, c1s, c2s, sbw + tb * 32, r32, hi);
        else    sgu_mma<4>(g, t0, m0, ytg, SU, sgu_w, sgu_b, lng, lnb, Ob, mu, rs, c1s, c2s, sbw + tb * 32, r32, hi);
    }
    asm volatile("" :: "v"(pf[0]), "v"(pf[1]));
    SGU_ACC(33);
    __syncthreads();
}

struct Args { const float* in[23]; float* out; unsigned char* ws; int ph_lo, ph_hi; };
constexpr int NPHASE = 10;

__global__ void __launch_bounds__(NWAVES * 64, 2) mk_fwd(Args args) {
    extern __shared__ __attribute__((aligned(16))) unsigned char lds_raw[];
    LAS unsigned char* lds = (LAS unsigned char*)lds_raw;
    volatile LAS unsigned* MISC = (volatile LAS unsigned*)(lds + MISC_OFF);
    const int tid = threadIdx.x, lane = tid & 63, wave = __builtin_amdgcn_readfirstlane(tid >> 6);
    const int G = gridDim.x, bx = blockIdx.x;
    const int vcu = (G % 8 == 0) ? (bx % 8) * (G / 8) + bx / 8 : bx;
    const int gw = vcu * NWAVES + wave, NGW = G * NWAVES;
    unsigned char* ws = args.ws;
    unsigned* ctl = (unsigned*)(ws + WS_CTL);
    const float* x = args.in[0]; const float* cvec = args.in[1]; const float* w_ada = args.in[2]; const float* b_ada = args.in[3]; const float* w_in = args.in[4];
    const float* sgu_w = args.in[5]; const float* sgu_b = args.in[6]; const float* sgu_lng = args.in[7]; const float* sgu_lnb = args.in[8];
    const float* w_pa = args.in[9]; const float* w_pb = args.in[10]; const float* w_out = args.in[11]; const float* ln1g = args.in[12]; const float* ln1b = args.in[13];
    const float* w_group = args.in[14]; const float* b_group = args.in[15]; const float* w_router = args.in[16]; const float* b_router = args.in[17];
    const float* w_gate = args.in[18]; const float* w_up = args.in[19]; const float* w_down = args.in[20]; const float* ln2g = args.in[21]; const float* ln2b = args.in[22];
    float* modp = (float*)(ws + WS_MODP); float* mod = (float*)(ws + WS_MOD);
    int* toklist = (int*)(ws + WS_TOK); int* asg = (int*)(ws + WS_ASG);
    bf16_t* Wab = (bf16_t*)(ws + WS_WAB); bf16_t* Wout = (bf16_t*)(ws + WS_WOUT); bf16_t* Wgu = (bf16_t*)(ws + WS_WGU); bf16_t* Wd = (bf16_t*)(ws + WS_WD); bf16_t* Win = (bf16_t*)(ws + WS_WIN);
    bf16_t* Hb = (bf16_t*)(ws + WS_H); bf16_t* Qb = (bf16_t*)(ws + WS_Q); bf16_t* Kb = (bf16_t*)(ws + WS_K); bf16_t* SUb = (bf16_t*)(ws + WS_SU); bf16_t* VTb = (bf16_t*)(ws + WS_VT);
    bf16_t* MRG = (bf16_t*)(ws + WS_MRG); bf16_t* YS = (bf16_t*)(ws + WS_YS); bf16_t* SAb = (bf16_t*)(ws + WS_SA); bf16_t* SBb = (bf16_t*)(ws + WS_SB);
    float* V1 = (float*)(ws + WS_V1); bf16_t* OAB = (bf16_t*)(ws + WS_OAB); bf16_t* HBb = (bf16_t*)(ws + WS_HB);
    bf16_t* Yb = (bf16_t*)(ws + WS_SU);
    unsigned char* Win8 = (unsigned char*)Win + (size_t)2048 * DM * 2;
    unsigned char* H8 = ws + WS_OAB;

    for (int u = tid; u < (LDS_BYTES - LDSCTL_OFF) / 4; u += NWAVES * 64) ((LAS unsigned*)(lds + LDSCTL_OFF))[u] = 0u;
    __syncthreads();
    XcdBarrier bar; bar.bar = ctl + CW_BAR; bar.x = 0; bar.st = nullptr;
#if !MK_PER_PHASE
    bar = xcd_barrier_post(ctl + CW_BAR, MISC + 8);
#define GRID_BAR() xcd_barrier(bar)
#else
#define GRID_BAR() do { } while (0)
#endif
    const int lo = args.ph_lo, hi_ph = args.ph_hi;
#ifndef TS_A
#define TS_A -1
#endif
#ifndef TS_B
#define TS_B 27
#endif
#ifndef TS_DIV
#define TS_DIV 1.0f
#endif
#define STAMP(k) do { if (TS_A >= 0 && tid == 0) ((volatile LAS unsigned long long*)(lds + LDSCTL_OFF + 1024))[k] = __builtin_amdgcn_s_memrealtime(); } while (0)
    STAMP(0);
#define ACC_BEGIN() do { if (TS_A >= 0 && tid == 0) { volatile LAS unsigned long long* t_ = (volatile LAS unsigned long long*)(lds + LDSCTL_OFF + 1024); t_[18] = __builtin_amdgcn_s_memrealtime(); } } while (0)
#define ACC_TO(slot) do { if (TS_A >= 0 && tid == 0) { volatile LAS unsigned long long* t_ = (volatile LAS unsigned long long*)(lds + LDSCTL_OFF + 1024); const unsigned long long n_ = __builtin_amdgcn_s_memrealtime(); t_[slot] += n_ - t_[18]; t_[18] = n_; } } while (0)
#ifndef PH_MASK
#define PH_MASK 0x3ff
#endif
#define IN(k) (((PH_MASK >> (k)) & 1) && lo <= (k) && (k) < hi_ph)
#define BOTH(k) (IN(k) && IN((k) + 1))
#ifndef REP_MASK
#define REP_MASK 0
#endif
#ifndef ATT_REP
#define ATT_REP 1
#endif
#ifndef SGU_REP
#define SGU_REP 1
#endif
#define NREP(k) ((((REP_MASK) >> (k)) & 1) ? 2 : 1)

    if (IN(0)) for (int rep_ = 0; rep_ < NREP(0); ++rep_) {
        LAS float* sl = (LAS float*)lds;
        for (int item = vcu; item < 256; item += G) {
            const int cc = item & 31, ks = item >> 5;
            { const int b = tid >> 8, kk = tid & 255; const float v = cvec[b * DM + ks * 256 + kk]; sl[tid] = v / (1.0f + __expf(-v)); }
            __syncthreads();
            const int cg = tid % 96, sub = tid / 96;
            f32x4 a0 = {0.f, 0.f, 0.f, 0.f}, a1 = {0.f, 0.f, 0.f, 0.f};
            if (sub < 4) {
                const float* wp = w_ada + (size_t)(ks * 256 + sub * 64) * MODW + cc * 384 + cg * 4;
#pragma unroll 8
                for (int i = 0; i < 64; ++i) { const f32x4 w = __builtin_nontemporal_load((const f32x4*)(wp + (size_t)i * MODW)); a0 += w * sl[sub * 64 + i]; a1 += w * sl[256 + sub * 64 + i]; }
            }
            LAS float* red = sl + 512;
            if (sub < 4) { *(LAS f32x4*)(red + (sub * 2 + 0) * 384 + cg * 4) = a0; *(LAS f32x4*)(red + (sub * 2 + 1) * 384 + cg * 4) = a1; }
            __syncthreads();
            if (tid < 192) { const int b = tid / 96, gq = tid % 96; f32x4 s = {0.f, 0.f, 0.f, 0.f};
#pragma unroll
                for (int sb = 0; sb < 4; ++sb) s += *(LAS f32x4*)(red + (sb * 2 + b) * 384 + gq * 4);
                *(f32x4*)(modp + ((size_t)ks * 2 + b) * MODW + cc * 384 + gq * 4) = s; }
            __syncthreads();
        }
        { int nd = 0; for (int item = vcu; item < 256; item += G) ++nd;
          asm volatile("s_waitcnt vmcnt(0)" ::: "memory");
          __syncthreads();
          if (tid == 0 && nd > 0) { __builtin_amdgcn_fence(__ATOMIC_RELEASE, "agent"); asm volatile("s_waitcnt vmcnt(0)" ::: "memory");
              __hip_atomic_fetch_add(ctl + CW_MODC, (unsigned)nd, __ATOMIC_RELAXED, __HIP_MEMORY_SCOPE_AGENT); } }
        { bf16_t* wrh = (bf16_t*)(ws + WS_WRT); bf16_t* wrl = wrh + 48 * DM;
          for (int idx = vcu * (NWAVES * 64) + tid; idx < 48 * DM; idx += G * NWAVES * 64) { const int c = idx >> 11, k = idx & (DM - 1);
              const float v = c < 32 ? w_router[(size_t)k * 32 + c] : (c < 36 ? w_group[(size_t)k * 4 + (c - 32)] : 0.f);
              const unsigned hb = f2bf(v); wrh[idx] = (bf16_t)hb; wrl[idx] = (bf16_t)f2bf(v - __uint_as_float(hb << 16)); } }
        LAS float* scr = (LAS float*)(lds + wave * 16384);
        constexpr int I_IN = 32 * 288, I_P = 16 * 64, I_O = 32 * 64, I_G = 32 * 16  , I_D = 8 * 64  ;
        constexpr int NITEMS = I_IN + 2 * I_P + I_O + NE * (2 * I_G + I_D);
        for (int it = gw; it < NITEMS; it += NGW) {
            int r = it;
            if (r < I_IN) { const int kb = r / 288, nb = r % 288, n0 = 32 * nb;
                if (win_is_bf16(n0)) transpose_item(w_in, DM, INC, Win, 64 * kb, n0, win_dst(n0) - n0, scr, lane);
                else transpose_item_fp8(w_in, DM, INC, Win8, 64 * kb, n0, win8_dst(n0) - n0, scr, lane);
                continue; } r -= I_IN;
            if (r < I_P) { const int kb = r / 64, nb = r % 64; transpose_item(w_pa, 1024, DM, Wab, 64 * kb, 32 * nb, 0, scr, lane); continue; } r -= I_P;
            if (r < I_P) { const int kb = r / 64, nb = r % 64; transpose_item(w_pb, 1024, DM, Wab, 64 * kb, 32 * nb, 2048, scr, lane); continue; } r -= I_P;
            if (r < I_O) { const int kb = r / 64, nb = r % 64; transpose_item(w_out, DM, DM, Wout, 64 * kb, 32 * nb, 0, scr, lane); continue; } r -= I_O;
            if (r < NE * I_G) { const int e = r / I_G, q = r % I_G, kb = q / 16, nb = q % 16, n0 = 32 * nb;
                transpose_item_fp8(w_gate + (size_t)e * DM * DE, DM, DE, (unsigned char*)Wgu + (size_t)e * 1024 * DM, 64 * kb, n0, 128 * (n0 / 128), scr, lane); continue; } r -= NE * I_G;
            if (r < NE * I_G) { const int e = r / I_G, q = r % I_G, kb = q / 16, nb = q % 16, n0 = 32 * nb;
                transpose_item_fp8(w_up + (size_t)e * DM * DE, DM, DE, (unsigned char*)Wgu + (size_t)e * 1024 * DM, 64 * kb, n0, 128 * (n0 / 128) + 128, scr, lane); continue; } r -= NE * I_G;
            { const int e = r / I_D, q = r % I_D, kb = q / 64, nb = q % 64;
                transpose_item_fp8(w_down + (size_t)e * DE * DM, DE, DM, (unsigned char*)Wd + (size_t)e * DM * DE, 64 * kb, 32 * nb, 0, scr, lane); }
        }
        if (rep_ + 1 < NREP(0)) GRID_BAR();
        STAMP(1);
    }

    if (IN(1)) for (int rep_ = 0; rep_ < NREP(1); ++rep_) {
        if (IN(0)) {
            if (tid == 0) { unsigned sp = 0; while (__hip_atomic_load(ctl + CW_MODC, RLX_AGENT) < 256u) { __builtin_amdgcn_s_sleep(2); if (++sp > (1u << 22)) break; }
                __builtin_amdgcn_fence(__ATOMIC_ACQUIRE, "agent"); asm volatile("s_waitcnt vmcnt(0)" ::: "memory"); }
            __syncthreads();
        }
        LAS float* ms = (LAS float*)lds;
        for (int idx = tid; idx < 8192; idx += NWAVES * 64) { const int b = idx >> 12, j = idx & 4095; float v = b_ada[j];
#pragma unroll
            for (int p = 0; p < 8; ++p) v += modp[((size_t)p * 2 + b) * MODW + j];
            ms[idx] = (j >= DM) ? 1.0f + v : v; }
        for (int idx = vcu * (NWAVES * 64) + tid; idx < 2 * MODW; idx += G * NWAVES * 64) { const int b = idx / MODW, j = idx % MODW; float v = b_ada[j];
#pragma unroll
            for (int p = 0; p < 8; ++p) v += modp[((size_t)p * 2 + b) * MODW + j];
            mod[idx] = v; }
        __syncthreads();
        for (int m = gw; m < M; m += NGW) {
            const int b = m >> 13;
            const f32x4* xr = (const f32x4*)(x + (size_t)m * DM) + lane;
            f32x4 v[8]; float s = 0.f;
#pragma unroll
            for (int j = 0; j < 8; ++j) { v[j] = xr[64 * j]; s += (v[j].x + v[j].y) + (v[j].z + v[j].w); }
            const float mean = wave_sum(s) * (1.0f / DM); float s2 = 0.f;
#pragma unroll
            for (int j = 0; j < 8; ++j) { v[j] = v[j] - mean; s2 += (v[j].x * v[j].x + v[j].y * v[j].y) + (v[j].z * v[j].z + v[j].w * v[j].w); }
            const float rstd = 1.0f / sqrtf(wave_sum(s2) * (1.0f / DM) + LN_EPS);
            u32x2* o8 = (u32x2*)(Hb + (size_t)m * DM) + lane; unsigned* o4 = (unsigned*)(H8 + (size_t)m * DM) + lane;
#pragma unroll
            for (int j = 0; j < 8; ++j) { const f32x4 sh = *(const LAS f32x4*)(ms + (b * 2) * DM + 256 * j + 4 * lane), sc = *(const LAS f32x4*)(ms + (b * 2 + 1) * DM + 256 * j + 4 * lane);
                const f32x4 hv = v[j] * rstd * sc + sh; u32x2 w; w.x = pk2(hv.x, hv.y); w.y = pk2(hv.z, hv.w); o8[64 * j] = w; o4[64 * j] = pk4_fp8(hv.x, hv.y, hv.z, hv.w); }
        }
        __syncthreads();
        if (BOTH(1) || rep_ + 1 < NREP(1)) GRID_BAR();
        STAMP(2);
    }

    if (IN(2)) for (int rep_ = 0; rep_ < NREP(2); ++rep_) {
        { pg8::Gemm g{Hb, Win, DM}; pg8::StaticOrder S; S.init(M, 2048, G, bx);
          pg8::EpiG1 E{Qb, Kb, SUb, SAb, SBb};
          pg8::gemm_phase<pg8::EpiG1, pg8::StaticOrder, true>(lds, g, S, E); }
        { pg8::Gemm g{(const bf16_t*)H8, (const bf16_t*)Win8, DM / 2}; pg8::StaticOrder S; S.init(M, 5120, G, bx);
          pg8::EpiGates E{SAb, SBb, SUb};
          pg8::gemm_phase<pg8::EpiGates, pg8::StaticOrder, true, true>(lds, g, S, E); }
        { pg8::Gemm g{(const bf16_t*)(Win8 + (size_t)5120 * DM), (const bf16_t*)H8, DM / 2}; pg8::StaticOrder S; S.init(2048, M, G, bx);
          pg8::EpiG2 E{VTb};
          pg8::gemm_phase<pg8::EpiG2, pg8::StaticOrder, true, true>(lds, g, S, E); }
        if (BOTH(2) || rep_ + 1 < NREP(2)) GRID_BAR();
        STAMP(3);
    }

    if (IN(3)) for (int rep_ = 0; rep_ < NREP(3); ++rep_) {
        ACC_BEGIN();
        const unsigned long long dbt0 = DBG_COUNT ? __builtin_amdgcn_s_memrealtime() : 0ull;
        for (int item2 = vcu; item2 < SGU_REP * 256; item2 += G) { const int item = item2 & 255;
            sgu_item(item >> 1, item & 1, VTb + (size_t)1024 * VTP, SUb, sgu_w, sgu_b, sgu_lng, sgu_lnb, OAB + (size_t)M * SBW, lds, tid); }
        ACC_TO(24);
        const unsigned long long dbt1 = DBG_COUNT ? __builtin_amdgcn_s_memrealtime() : 0ull;
        for (int U2 = gw; U2 < ATT_REP * BATCH * NHEAD * (SEQ / 32); U2 += NGW) {
            const int U = U2 % (BATCH * NHEAD * (SEQ / 32));
            const int bh = U >> 8, qb = U & 255;
            sb_attn_unit(bh >> 3, bh & 7, qb, Qb, Kb, VTb, OAB, lds + wave * 16384, lane, ctl + 3000);
        }
        ACC_TO(25);
        if (DBG_COUNT && lane == 0) { const unsigned long long dbt2 = __builtin_amdgcn_s_memrealtime();
            atomicMax(ctl + 3001, (unsigned)(dbt1 - dbt0)); atomicMax(ctl + 3002, (unsigned)(dbt2 - dbt1)); atomicAdd(ctl + 3003, (unsigned)(dbt2 - dbt1)); atomicMin(ctl + 3004, 0xffffffffu - (unsigned)(dbt2 - dbt1)); }
        if (BOTH(3) || rep_ + 1 < NREP(3)) GRID_BAR();
        STAMP(4);
    }

    if (IN(4)) for (int rep_ = 0; rep_ < NREP(4); ++rep_) {
        pg8::Gemm g{OAB, Wab, 1024}; pg8::PairOrder S; S.so.init(M, DM, G, bx);
        pg8::EpiGate E{SAb, SBb, MRG};
        pg8::gemm_phase<pg8::EpiGate, pg8::PairOrder, true>(lds, g, S, E);
        if (BOTH(4) || rep_ + 1 < NREP(4)) GRID_BAR();
        STAMP(5);
    }

    if (IN(5)) for (int rep_ = 0; rep_ < NREP(5); ++rep_) {
        pg8::Gemm g{MRG, Wout, DM}; pg8::StaticOrder S; S.init(M, DM, G, bx);
        pg8::EpiY E{Yb};
        pg8::gemm_phase<pg8::EpiY, pg8::StaticOrder, true>(lds, g, S, E);
        if (BOTH(5) || rep_ + 1 < NREP(5)) GRID_BAR();
        STAMP(6);
    }

    if (IN(6)) for (int rep_ = 0; rep_ < NREP(6); ++rep_) {
        constexpr int ROWB = 2064, PLANE = 16 * ROWB;
        LAS unsigned char* thi = lds; LAS unsigned char* tlo = lds + PLANE;
        LAS float* red = (LAS float*)lds;
        LAS float* pv = (LAS float*)(lds + 2 * PLANE);
        LAS int* rl = (LAS int*)(lds + 2 * PLANE + 5 * 8192);
        const bf16_t* wrh = (const bf16_t*)(ws + WS_WRT); const bf16_t* wrl = wrh + 48 * DM;
        int pvb = -1;
        __syncthreads();
        for (int idx = tid; idx < 2048; idx += NWAVES * 64) { pv[idx] = ln1g[idx]; pv[2048 + idx] = ln1b[idx]; }
        for (int it0 = vcu; it0 < M / 16; it0 += 4 * G) {
        if (tid < 32) rl[tid] = 0;
        __syncthreads();
        for (int ii = 0; ii < 4; ++ii) {
            const int it = it0 + ii * G; if (it >= M / 16) break;
            const int mbase = it * 16 + wave * 2, bq = it >> 9;
            if (bq != pvb) {
                __syncthreads();
                for (int idx = tid; idx < 2048; idx += NWAVES * 64) { pv[4096 + idx] = mod[(size_t)bq * MODW + 3 * DM + idx]; pv[6144 + idx] = 1.0f + mod[(size_t)bq * MODW + 4 * DM + idx]; pv[8192 + idx] = mod[(size_t)bq * MODW + 2 * DM + idx]; }
                pvb = bq;
                __syncthreads();
            }
            ACC_BEGIN();
            const int arow = lane & 15, kg = lane >> 4;
            bf16x8 wfh[4][3], wfl[4][3];
#define P6_LOADWF(dst, src, hh_) do { int ar_ = arow; asm volatile("" : "+v"(ar_));   \
                _Pragma("unroll") for (int cb = 0; cb < 3; ++cb) { const bf16_t* wp_ = src + (size_t)(cb * 16 + ar_) * DM + 1024 * (hh_) + 128 * wave + 8 * kg; \
                    _Pragma("unroll") for (int ks = 0; ks < 4; ++ks) dst[ks][cb] = *(const bf16x8*)(wp_ + 32 * ks); } } while (0)
            P6_LOADWF(wfh, wrh, 0); P6_LOADWF(wfl, wrl, 0);
            f32x4 h2v[2][4];
#pragma unroll
            for (int rr = 0; rr < 2; ++rr) {
                int lane_o = lane; asm volatile("" : "+v"(lane_o));
                u32x2* vr = (u32x2*)((bf16_t*)V1 + (size_t)(mbase + rr) * DM) + lane_o;
                const f32x4* xr = (const f32x4*)(x + (size_t)(mbase + rr) * DM) + lane_o; const u32x2* yr = (const u32x2*)(Yb + (size_t)(mbase + rr) * DM) + lane_o;
                f32x4 v[8]; u32x2 yv[8]; float s = 0.f;
#pragma unroll
                for (int j = 0; j < 8; ++j) { v[j] = xr[64 * j]; yv[j] = yr[64 * j]; }
#pragma unroll
                for (int j = 0; j < 8; ++j) { const f32x4 g1 = *(const LAS f32x4*)(pv + 4 * 2048 + 256 * j + 4 * lane_o);
                    const f32x4 yf = {bflo(yv[j].x), bfhi(yv[j].x), bflo(yv[j].y), bfhi(yv[j].y)};
                    v[j] = v[j] * ALPHA + g1 * yf; s += (v[j].x + v[j].y) + (v[j].z + v[j].w); __builtin_amdgcn_sched_barrier(0); }
                float mean = wave_sum(s) * (1.0f / DM); float s2 = 0.f;
#pragma unroll
                for (int j = 0; j < 8; ++j) { v[j] = v[j] - mean; s2 += (v[j].x * v[j].x + v[j].y * v[j].y) + (v[j].z * v[j].z + v[j].w * v[j].w); }
                float rstd = 1.0f / sqrtf(wave_sum(s2) * (1.0f / DM) + LN_EPS);
                s = 0.f;
#pragma unroll
                for (int j = 0; j < 8; ++j) { const f32x4 gq = *(const LAS f32x4*)(pv + 256 * j + 4 * lane_o), bb = *(const LAS f32x4*)(pv + 2048 + 256 * j + 4 * lane_o);
                    v[j] = v[j] * rstd * gq + bb; { u32x2 w_; w_.x = pk2(v[j].x, v[j].y); w_.y = pk2(v[j].z, v[j].w); vr[64 * j] = w_; } s += (v[j].x + v[j].y) + (v[j].z + v[j].w); __builtin_amdgcn_sched_barrier(0); }
                mean = wave_sum(s) * (1.0f / DM); s2 = 0.f;
#pragma unroll
                for (int j = 0; j < 8; ++j) { const f32x4 d = v[j] - mean; s2 += (d.x * d.x + d.y * d.y) + (d.z * d.z + d.w * d.w); }
                rstd = 1.0f / sqrtf(wave_sum(s2) * (1.0f / DM) + LN_EPS);
                unsigned* ho = (unsigned*)((unsigned char*)Hb + (size_t)(mbase + rr) * DM) + lane_o;
#pragma unroll
                for (int j = 0; j < 8; ++j) { const f32x4 sh = *(const LAS f32x4*)(pv + 2 * 2048 + 256 * j + 4 * lane_o), sc = *(const LAS f32x4*)(pv + 3 * 2048 + 256 * j + 4 * lane_o);
                    const f32x4 hv = (v[j] - mean) * rstd * sc + sh; ho[64 * j] = pk4_fp8(hv.x, hv.y, hv.z, hv.w);
                    if (j >= 4) h2v[rr][j - 4] = hv;
                    else { u32x2 hb; hb.x = pk2(hv.x, hv.y); hb.y = pk2(hv.z, hv.w);
                        u32x2 lb; lb.x = pk2(hv.x - bflo(hb.x), hv.y - bfhi(hb.x)); lb.y = pk2(hv.z - bflo(hb.y), hv.w - bfhi(hb.y));
                        *(LAS u32x2*)(thi + (wave * 2 + rr) * ROWB + 8 * lane_o + 512 * j) = hb; *(LAS u32x2*)(tlo + (wave * 2 + rr) * ROWB + 8 * lane_o + 512 * j) = lb; }
                    __builtin_amdgcn_sched_barrier(0); }
            }
            ACC_TO(20);
            f32x4 lacc[3];
#pragma unroll
            for (int cb = 0; cb < 3; ++cb) lacc[cb] = (f32x4){0.f, 0.f, 0.f, 0.f};
#pragma unroll 1
            for (int hh = 0; hh < 2; ++hh) {
                if (hh == 1) {
#pragma unroll
                for (int rr = 0; rr < 2; ++rr) {
                    LAS unsigned char* dh = thi + (wave * 2 + rr) * ROWB + 8 * lane; LAS unsigned char* dl = tlo + (wave * 2 + rr) * ROWB + 8 * lane;
#pragma unroll
                    for (int j = 0; j < 4; ++j) { const f32x4 hv = h2v[rr][j];
                        u32x2 hb; hb.x = pk2(hv.x, hv.y); hb.y = pk2(hv.z, hv.w);
                        u32x2 lb; lb.x = pk2(hv.x - bflo(hb.x), hv.y - bfhi(hb.x)); lb.y = pk2(hv.z - bflo(hb.y), hv.w - bfhi(hb.y));
                        *(LAS u32x2*)(dh + 512 * j) = hb; *(LAS u32x2*)(dl + 512 * j) = lb; }
                } }
                asm volatile("s_waitcnt lgkmcnt(0)" ::: "memory"); __builtin_amdgcn_s_barrier(); asm volatile("" ::: "memory");
                bf16x8 ah[4], al[4];
#pragma unroll
                for (int ks = 0; ks < 4; ++ks) { const int ko = (128 * wave + 32 * ks + 8 * kg) * 2; ah[ks] = *(const LAS bf16x8*)(thi + arow * ROWB + ko); al[ks] = *(const LAS bf16x8*)(tlo + arow * ROWB + ko); }
#pragma unroll
                for (int ks = 0; ks < 4; ++ks)
#pragma unroll
                    for (int cb = 0; cb < 3; ++cb) { lacc[cb] = __builtin_amdgcn_mfma_f32_16x16x32_bf16(ah[ks], wfh[ks][cb], lacc[cb], 0, 0, 0); lacc[cb] = __builtin_amdgcn_mfma_f32_16x16x32_bf16(al[ks], wfh[ks][cb], lacc[cb], 0, 0, 0); }
#pragma unroll
                for (int ks = 0; ks < 4; ++ks)
#pragma unroll
                    for (int cb = 0; cb < 3; ++cb) lacc[cb] = __builtin_amdgcn_mfma_f32_16x16x32_bf16(ah[ks], wfl[ks][cb], lacc[cb], 0, 0, 0);
                asm volatile("" : "+v"(lacc[0]), "+v"(lacc[1]), "+v"(lacc[2]));
                if (hh == 0) { P6_LOADWF(wfh, wrh, 1); P6_LOADWF(wfl, wrl, 1); }
                asm volatile("s_waitcnt lgkmcnt(0)" ::: "memory"); __builtin_amdgcn_s_barrier(); asm volatile("" ::: "memory");
            }
            ACC_TO(21);
#pragma unroll
            for (int cb = 0; cb < 3; ++cb)
#pragma unroll
                for (int rg = 0; rg < 4; ++rg) red[(wave * 16 + 4 * kg + rg) * 48 + cb * 16 + arow] = lacc[cb][rg];
            __syncthreads();
            if (tid < 16) {
                float l[36];
#pragma unroll
                for (int c = 0; c < 36; ++c) l[c] = (c < 32 ? b_router[c] : b_group[c - 32]);
#pragma unroll 1
                for (int w = 0; w < 8; ++w) { const LAS f32x4* rp = (const LAS f32x4*)(red + (w * 16 + tid) * 48);
#pragma unroll
                    for (int q4 = 0; q4 < 9; ++q4) { const f32x4 t = rp[q4]; l[4 * q4] += t[0]; l[4 * q4 + 1] += t[1]; l[4 * q4 + 2] += t[2]; l[4 * q4 + 3] += t[3]; } }
                int gs = 0; float gm = l[32];
#pragma unroll
                for (int q = 1; q < 4; ++q) if (l[32 + q] > gm) { gm = l[32 + q]; gs = q; }
                float den = 0.f;
#pragma unroll
                for (int q = 0; q < 4; ++q) den += __expf(l[32 + q] - gm);
                const float pg = 1.0f / den;
                int i0 = 0, i1 = 1; float v0 = 0.f, v1 = 0.f;
#pragma unroll
                for (int q = 0; q < 4; ++q) {
                    int a0 = 0; float b0 = l[8 * q];
#pragma unroll
                    for (int j = 1; j < 8; ++j) if (l[8 * q + j] > b0) { b0 = l[8 * q + j]; a0 = j; }
                    int a1 = -1; float b1 = -3.0e38f;
#pragma unroll
                    for (int j = 0; j < 8; ++j) if (j != a0 && l[8 * q + j] > b1) { b1 = l[8 * q + j]; a1 = j; }
                    if (q == gs) { i0 = a0; i1 = a1; v0 = b0; v1 = b1; }
                }
                const float e1 = __expf(v1 - v0), w0 = pg / (1.0f + e1), w1 = pg * e1 / (1.0f + e1);
                const int x0 = gs * 8 + i0, x1 = gs * 8 + i1;
                const int p0 = __hip_atomic_fetch_add(rl + x0, 1, __ATOMIC_RELAXED, __HIP_MEMORY_SCOPE_WORKGROUP), p1 = __hip_atomic_fetch_add(rl + x1, 1, __ATOMIC_RELAXED, __HIP_MEMORY_SCOPE_WORKGROUP);
                const int a = (ii * 16 + tid) * 2;
                rl[64 + a] = x0; rl[64 + a + 1] = x1; rl[192 + a] = p0; rl[192 + a + 1] = p1; rl[320 + a] = __float_as_int(w0); rl[320 + a + 1] = __float_as_int(w1);
            }
            __syncthreads();
            ACC_TO(22);
        }
        __syncthreads();
        ACC_BEGIN();
        if (tid < 32) { const int c = rl[tid]; rl[32 + tid] = c > 0 ? (int)atomicAdd(ctl + CW_CNT + 64 * tid, (unsigned)c) : 0; }
        __syncthreads();
        if (tid < 128) { const int ii = tid >> 5, it = it0 + ii * G;
            if (it < M / 16) { const int m = it * 16 + ((tid & 31) >> 1), kq = tid & 1, a = tid;
                const int e = rl[64 + a], pos = rl[32 + e] + rl[192 + a];
                toklist[e * ECAP + pos] = m;
                int* ag = asg + (size_t)m * 8 + 4 * kq;
                ag[0] = e; ag[1] = pos; ag[2] = rl[320 + a]; ag[3] = 0; } }
        __syncthreads();
        ACC_TO(23);
        }
        __syncthreads();
        if (BOTH(6) || rep_ + 1 < NREP(6)) GRID_BAR();
        STAMP(7);
    }

    LAS int* tp = (LAS int*)(lds + LDSCTL_OFF);
#define BUILD_TP() do { __syncthreads(); if (tid == 0) { int acc_ = 0; for (int e_ = 0; e_ < NE; ++e_) { const int c_ = (int)__hip_atomic_load(ctl + CW_CNT + 64 * e_, RLX_AGENT); tp[e_] = acc_; tp[40 + e_] = c_; acc_ += (c_ + 255) >> 8; } tp[32] = acc_; } __syncthreads(); } while (0)

    if (IN(7)) for (int rep_ = 0; rep_ < NREP(7); ++rep_) {
        BUILD_TP();
        pg8::Gemm g{Hb, Wgu, DM / 2}; pg8::MoeOrder<true, 2> S{tp, toklist, G, bx, tp[32] * 4};
        pg8::EpiGU E{(unsigned char*)HBb};
        pg8::gemm_phase<pg8::EpiGU, pg8::MoeOrder<true, 2>, true, true>(lds, g, S, E);
        if (BOTH(7) || rep_ + 1 < NREP(7)) GRID_BAR();
        STAMP(8);
    }

    if (IN(8)) for (int rep_ = 0; rep_ < NREP(8); ++rep_) {
        BUILD_TP();
        int kq8 = DE / 2; asm volatile("" : "+s"(kq8));
        pg8::Gemm g{HBb, Wd, kq8}; pg8::MoeOrder<false, 3> S{tp, toklist, G, bx, tp[32] * 8};
        pg8::EpiDown E{(unsigned char*)YS};
        pg8::gemm_phase<pg8::EpiDown, pg8::MoeOrder<false, 3>, true, true>(lds, g, S, E);
        if (BOTH(8) || rep_ + 1 < NREP(8)) GRID_BAR();
        STAMP(9);
    }

    if (IN(9)) for (int rep_ = 0; rep_ < NREP(9); ++rep_) {
        BUILD_TP();
        for (int m = gw; m < M; m += NGW) {
            const int b = m >> 13;
            const int* ag = asg + (size_t)m * 8;
            const int e0 = ag[0], p0 = ag[1], e1 = ag[4], p1 = ag[5]; const float w0 = __int_as_float(ag[2]), w1 = __int_as_float(ag[6]);
            const size_t r0 = (size_t)tp[e0] * 256 + p0, r1 = (size_t)tp[e1] * 256 + p1;
            const u32x2* xr = (const u32x2*)((const bf16_t*)V1 + (size_t)m * DM) + lane;
            const unsigned* y0 = (const unsigned*)((const unsigned char*)YS + r0 * DM) + lane; const unsigned* y1 = (const unsigned*)((const unsigned char*)YS + r1 * DM) + lane;
            const f32x4* g2 = (const f32x4*)(mod + (size_t)b * MODW + 5 * DM) + lane;
            f32x4 v[8]; float s = 0.f;
#pragma unroll
            for (int j = 0; j < 8; ++j) { const u32x2 xb_ = xr[64 * j]; const f32x4 xv = {bflo(xb_.x), bfhi(xb_.x), bflo(xb_.y), bfhi(xb_.y)}, gq = g2[64 * j]; const int a = (int)y0[64 * j], c = (int)y1[64 * j];
                const f32x4 ya = {__builtin_amdgcn_cvt_f32_fp8(a, 0), __builtin_amdgcn_cvt_f32_fp8(a, 1), __builtin_amdgcn_cvt_f32_fp8(a, 2), __builtin_amdgcn_cvt_f32_fp8(a, 3)},
                            yc = {__builtin_amdgcn_cvt_f32_fp8(c, 0), __builtin_amdgcn_cvt_f32_fp8(c, 1), __builtin_amdgcn_cvt_f32_fp8(c, 2), __builtin_amdgcn_cvt_f32_fp8(c, 3)};
                v[j] = xv * ALPHA + gq * (ya * w0 + yc * w1); s += (v[j].x + v[j].y) + (v[j].z + v[j].w); }
            const float mean = wave_sum(s) * (1.0f / DM); float s2 = 0.f;
#pragma unroll
            for (int j = 0; j < 8; ++j) { v[j] = v[j] - mean; s2 += (v[j].x * v[j].x + v[j].y * v[j].y) + (v[j].z * v[j].z + v[j].w * v[j].w); }
            const float rstd = 1.0f / sqrtf(wave_sum(s2) * (1.0f / DM) + LN_EPS);
            f32x4* orow = (f32x4*)(args.out + (size_t)m * DM) + lane;
#pragma unroll
            for (int j = 0; j < 8; ++j) { const f32x4 gq = *((const f32x4*)ln2g + 64 * j + lane), bq = *((const f32x4*)ln2b + 64 * j + lane); orow[64 * j] = v[j] * rstd * gq + bq; }
        }
        if (rep_ + 1 < NREP(9)) GRID_BAR();
        STAMP(10);
        if (TS_A >= 0) { __syncthreads(); if (bx == 0 && tid == 0) { volatile LAS unsigned long long* tsv = (volatile LAS unsigned long long*)(lds + LDSCTL_OFF + 1024);
            asm volatile("s_waitcnt vmcnt(0)" ::: "memory"); args.out[0] = DBG_COUNT == 1 ? (float)__hip_atomic_load(ctl + 3000, RLX_AGENT) * (1.0f / 4096.0f) : DBG_COUNT == 2 ? (float)__hip_atomic_load(ctl + 3001, RLX_AGENT) * 0.0025f : DBG_COUNT == 3 ? (float)__hip_atomic_load(ctl + 3002, RLX_AGENT) * 0.0025f : DBG_COUNT == 4 ? (float)__hip_atomic_load(ctl + 3003, RLX_AGENT) * (0.0025f / 2048.0f) : (float)(tsv[TS_B] - tsv[TS_A > 0 ? TS_A : 0]) * (0.01f / TS_DIV); } }
    }
#undef IN
#undef BOTH
}

extern "C" void kernel_launch(void* const* d_in, const int* in_sizes, int n_in, void* d_out, int out_size, void* d_ws, size_t ws_size, hipStream_t stream) {
    static int grid = 0;
    if (grid == 0) {
        if (n_in != 23 || in_sizes[0] != M * DM || out_size != M * DM || ws_size < WS_END) {
            fprintf(stderr, "kernel_launch: unexpected shapes (n_in %d, in0 %d, out %d, ws %zu); nothing launched\n", n_in, n_in > 0 ? in_sizes[0] : -1, out_size, ws_size); grid = -1; return; }
        int dev = 0, cus = 0, per_cu = 0;
        if (hipGetDevice(&dev) != hipSuccess || hipDeviceGetAttribute(&cus, hipDeviceAttributeMultiprocessorCount, dev) != hipSuccess) { fprintf(stderr, "kernel_launch: device query failed\n"); grid = -1; return; }
        if (hipFuncSetAttribute((const void*)mk_fwd, hipFuncAttributeMaxDynamicSharedMemorySize, LDS_BYTES) != hipSuccess) { fprintf(stderr, "kernel_launch: hipFuncSetAttribute failed\n"); grid = -1; return; }
        if (hipOccupancyMaxActiveBlocksPerMultiprocessor(&per_cu, (const void*)mk_fwd, NWAVES * 64, LDS_BYTES) != hipSuccess || per_cu < 1)
            fprintf(stderr, "kernel_launch: note: occupancy query reports %d workgroups per CU\n", per_cu);
        (void)hipGetLastError();
        grid = cus;
    }
    if (grid < 0) return;
    if (hipMemsetAsync((char*)d_ws + WS_CTL, 0, CTL_ZERO_BYTES, stream) != hipSuccess) { fprintf(stderr, "kernel_launch: memset failed\n"); return; }
    Args a{};
    for (int i = 0; i < 23; ++i) a.in[i] = (const float*)d_in[i];
    a.out = (float*)d_out; a.ws = (unsigned char*)d_ws;
#if MK_PER_PHASE
    for (int p = 0; p < NPHASE; ++p) { a.ph_lo = p; a.ph_hi = p + 1; hipLaunchKernelGGL(mk_fwd, dim3(grid), dim3(NWAVES * 64), LDS_BYTES, stream, a); }
#else
    a.ph_lo = 0; a.ph_hi = NPHASE;
    hipLaunchKernelGGL(mk_fwd, dim3(grid), dim3(NWAVES * 64), LDS_BYTES, stream, a);
#endif
    const hipError_t le = hipPeekAtLastError();
    if (le != hipSuccess) fprintf(stderr, "kernel_launch: launch failed: %s\n", hipGetErrorName(le));
}
```

```cpp
#include <hip/hip_runtime.h>
#include <cstdio>
#include <cstdint>

#ifndef MK_PER_PHASE
#define MK_PER_PHASE 0
#endif

#define GAS __attribute__((address_space(1)))
#define LAS __attribute__((address_space(3)))
typedef unsigned short bf16_t;
typedef short bf16x8 __attribute__((ext_vector_type(8)));
typedef short s16x4 __attribute__((ext_vector_type(4)));
typedef float f32x2 __attribute__((ext_vector_type(2)));
typedef float f32x4 __attribute__((ext_vector_type(4)));
typedef float f32x16 __attribute__((ext_vector_type(16)));
typedef unsigned u32x2 __attribute__((ext_vector_type(2)));
typedef unsigned u32x4 __attribute__((ext_vector_type(4)));
typedef __bf16 bf16x2_t __attribute__((ext_vector_type(2)));

constexpr int BATCH = 2, SEQ = 8192, DM = 2048, M = BATCH * SEQ;
constexpr int NHEAD = 8, HD = 128, SBW = 1024, SGW = 1024;
constexpr int INC = 9216, N1 = 7168;
constexpr int NE = 32, DE = 512, ECAP = 16384;
constexpr int MODW = 6 * DM;
constexpr float LN_EPS = 1e-5f;
constexpr float ALPHA = 1.189207115002721f;
constexpr float QSCALE = 0.08838834764831845f * 1.4426950408889634f;
constexpr int VTP = M + 128;
constexpr int HBROWS = 40960;

constexpr size_t MiB = 1u << 20;
constexpr size_t WS_CTL = 0, CTL_ZERO_BYTES = 65536;
constexpr size_t WS_MODP = 1 * MiB;
constexpr size_t WS_MOD = 2 * MiB;
constexpr size_t WS_WRT = 2 * MiB + 256 * 1024;
constexpr size_t WS_TOK = 3 * MiB;
constexpr size_t WS_ASG = 5 * MiB;
constexpr size_t WS_WAB = 6 * MiB;
constexpr size_t WS_WOUT = 14 * MiB;
constexpr size_t WS_WGU = 22 * MiB;
constexpr size_t WS_WD = 150 * MiB;
constexpr size_t WS_WIN = 214 * MiB;
constexpr int HP = DM + 64;
constexpr size_t WS_H = 248 * MiB;
constexpr size_t WS_Q = 314 * MiB, WS_K = 346 * MiB, WS_SU = 378 * MiB, WS_VT = 410 * MiB;
constexpr size_t WS_MRG = 475 * MiB;
constexpr size_t WS_YS = 314 * MiB;
constexpr int GP = DM + 64;
constexpr size_t WS_SA = 475 * MiB, WS_SB = 541 * MiB;
constexpr size_t WS_V1 = 475 * MiB;
constexpr size_t WS_OAB = 607 * MiB;
constexpr size_t WS_HB = 607 * MiB;
constexpr size_t WS_END = 671 * MiB;
constexpr int CW_CNT = 64;
constexpr int CW_MODC = 3008;
constexpr int CW_P0D = 3072;
constexpr int CW_XD = 3200;
constexpr int CW_BAR = 4096;
constexpr int CW_TILE = 8192;

constexpr int RING_BYTES = 131072;
constexpr int LDSCTL_OFF = RING_BYTES, MISC_OFF = LDSCTL_OFF + 320;
constexpr int LDS_BYTES = 147456;
constexpr int NWAVES = 8;

#define RLX_AGENT __ATOMIC_RELAXED, __HIP_MEMORY_SCOPE_AGENT
#define LDS_WAIT() asm volatile("s_waitcnt lgkmcnt(0)" ::: "memory")
__device__ __forceinline__ unsigned f2bf(float f) { unsigned u = __builtin_bit_cast(unsigned, f); return (u + 0x7fffu + ((u >> 16) & 1u)) >> 16; }
__device__ __forceinline__ unsigned pk2(float lo, float hi) { f32x2 v = {lo, hi}; bf16x2_t b = __builtin_convertvector(v, bf16x2_t); return __builtin_bit_cast(unsigned, b); }
__device__ __forceinline__ unsigned pk4_fp8(float a, float b, float c, float d) { int p = __builtin_amdgcn_cvt_pk_fp8_f32(a, b, 0, false); p = __builtin_amdgcn_cvt_pk_fp8_f32(c, d, p, true); return (unsigned)p; }
__device__ __forceinline__ float bflo(unsigned u) { return __uint_as_float(u << 16); }
__device__ __forceinline__ float bfhi(unsigned u) { return __uint_as_float(u & 0xffff0000u); }
template <int CTRL> __device__ __forceinline__ float dpp_mov(float v) { return __int_as_float(__builtin_amdgcn_update_dpp(0, __float_as_int(v), CTRL, 0xF, 0xF, false)); }
__device__ __forceinline__ float xor16_sum(float v) { auto r = __builtin_amdgcn_permlane16_swap(__float_as_uint(v), __float_as_uint(v), false, false); return __uint_as_float(r[0]) + __uint_as_float(r[1]); }
__device__ __forceinline__ float xor32_sum(float v) { auto r = __builtin_amdgcn_permlane32_swap(__float_as_uint(v), __float_as_uint(v), false, false); return __uint_as_float(r[0]) + __uint_as_float(r[1]); }
__device__ __forceinline__ float xor32_get(float v, int hi) { auto r = __builtin_amdgcn_permlane32_swap(__float_as_uint(v), __float_as_uint(v), false, false); return __uint_as_float(hi ? r[0] : r[1]); }
__device__ __forceinline__ float wave_sum(float v) {
    v += dpp_mov<0xB1>(v);
    v += dpp_mov<0x4E>(v);
    v += dpp_mov<0x124>(v);
    v += dpp_mov<0x128>(v);
    v = xor16_sum(v);
    return xor32_sum(v);
}
__device__ __forceinline__ float sigmoidf_(float x) { return __builtin_amdgcn_rcpf(1.0f + __builtin_amdgcn_exp2f(-1.4426950408889634f * x)); }
__device__ __forceinline__ f32x2 gelu_pk(f32x2 v) {
    const f32x2 av = __builtin_elementwise_abs(v), d = av * 0.2316418882f + 1.0f;
    f32x2 t; t.x = __builtin_amdgcn_rcpf(d.x); t.y = __builtin_amdgcn_rcpf(d.y);
    f32x2 q = t * 0.5307027145f + (-0.7265760135f); q = q * t + 0.7107068705f; q = q * t + (-0.142248368f); q = q * t + 0.127414796f; q = q * t;
    const f32x2 s = (v * v) * (-0.72134752044f);
    f32x2 e; e.x = __builtin_amdgcn_exp2f(s.x); e.y = __builtin_amdgcn_exp2f(s.y);
    const f32x2 m = v * (q * e), r = v - m;
    f32x2 o; o.x = v.x < 0.f ? m.x : r.x; o.y = v.y < 0.f ? m.y : r.y; return o;
}
__device__ __forceinline__ int xcd_remap(int L, int nwg) { const int q = nwg / 8, r = nwg % 8, xcd = L % 8, off = L / 8; return (xcd < r ? xcd * (q + 1) : r * (q + 1) + (xcd - r) * q) + off; }

__device__ __forceinline__ void st16u_sc1(void* p, u32x4 v) { asm volatile("global_store_dwordx4 %0, %1, off sc1\n\ts_nop 1" :: "v"(p), "v"(v)); }
__device__ __forceinline__ void st8u_sc1(void* p, u32x2 v) { asm volatile("global_store_dwordx2 %0, %1, off sc1\n\ts_nop 1" :: "v"(p), "v"(v)); }
__device__ __forceinline__ void st16_sc1(void* p, f32x4 v) { asm volatile("global_store_dwordx4 %0, %1, off sc1\n\ts_nop 1" :: "v"(p), "v"(v)); }
#ifndef GP_PROBE
#define GP_PROBE 0
#endif
#ifndef GP_PROBE_EPI
#define GP_PROBE_EPI EpiGates
#endif
#define GP_ACC(slot) do { if constexpr (GP_PROBE && __is_same(Epi, GP_PROBE_EPI)) { if (tid == 0) { volatile LAS unsigned long long* t_ = (volatile LAS unsigned long long*)(lds + 131072 + 1024); const unsigned long long n_ = __builtin_amdgcn_s_memrealtime(); t_[slot] += n_ - t_[18]; t_[18] = n_; } } } while (0)
namespace pg8 {
constexpr int BM = 256, BK = 64, HALF = 128, HTB = HALF * BK * 2, STAGE_BYTES = 8 * HTB, NXCD = 8, WGM = 8;
__host__ __device__ __forceinline__ int lds_byte(int r, int c) { const int st = (r >> 4) * 2 + (c >> 5), rr = r & 15, cc = c & 31, ob = rr * 64 + cc * 2; return st * 1024 + (ob ^ (((ob >> 9) & 1) << 5)); }
__host__ __device__ __forceinline__ void stage_rc(int b, int& R, int& C) { const int st = b / 1024, sb = b % 1024, swz = sb ^ (((sb >> 9) & 1) << 5); R = (st >> 1) * 16 + swz / 64; C = (st & 1) * 32 + (swz % 64) / 2; }
__host__ __device__ __forceinline__ int lds_byte8(int r, int c) { const int st = (r >> 4) * 2 + (c >> 5), rr = r & 15, cc = c & 31, ob = rr * 64 + cc * 2; return st * 1024 + (ob ^ (((ob >> 9) & 1) * 0x30)); }
__host__ __device__ __forceinline__ void stage_rc8(int b, int& R, int& C) { const int st = b / 1024, sb = b % 1024, swz = sb ^ (((sb >> 9) & 1) * 0x30); R = (st >> 1) * 16 + swz / 64; C = (st & 1) * 32 + (swz % 64) / 2; }
__host__ __device__ __forceinline__ int perm32(int rho) { const int n = rho >> 4, i = rho & 15; return 8 * (i >> 2) + 4 * n + (i & 3); }

struct Unit { int pm, pn, ax, ax2; };
struct Gemm { const bf16_t* A; const bf16_t* Bt; int K; int lda = 0; int ldb = 0; };

struct StaticOrder {
    static constexpr bool GATHER = false;
    int nM, nN, nwg, G, c;
    __device__ void init(int Mr, int Nr, int G_, int c_) { nM = Mr / BM; nN = Nr / BM; nwg = nM * nN; G = G_; c = c_; }
    __device__ bool next(int i, Unit& u) const {
        const long L = (long)i * G + c; if (L >= nwg) return false;
        const int wgid = xcd_remap((int)L, nwg);
        const int nig = WGM * nN, gid = wgid / nig, fm = gid * WGM, gsz = (nM - fm) < WGM ? (nM - fm) : WGM;
        u.pm = fm + ((wgid % nig) % gsz); u.pn = (wgid % nig) / gsz; u.ax = 0; u.ax2 = 0; return true;
    }
    __device__ __forceinline__ int row_src(const Unit&, int) const { return 0; }
};
struct PairOrder {
    static constexpr bool GATHER = false;
    StaticOrder so;
    __device__ bool next(int i, Unit& u) const { Unit t; if (!so.next(i >> 1, t)) return false; const int hf = i & 1; u.pm = t.pm + 64 * hf; u.pn = t.pn + 8 * hf; u.ax = hf; u.ax2 = 0; return true; }
    __device__ __forceinline__ int row_src(const Unit&, int) const { return 0; }
};
template <bool G_, int SH> struct MoeOrder {
    static constexpr bool GATHER = G_;
    const LAS int* tp;
    const int* tok;
    int G, c, total;
    int xl, t0, cnt, rank;
    const unsigned* dep;
    __device__ bool next(int i, Unit& u) const {
        int wgid;
        if (xl) { wgid = i * 32 + rank; if (wgid >= cnt) return false; wgid += t0 << SH; }
        else { const long L = (long)i * G + c; if (L >= total) return false; wgid = xcd_remap((int)L, total); }
        const int tile = wgid >> SH, pn = wgid & ((1 << SH) - 1);
        if (dep) { unsigned sp_ = 0; while (__hip_atomic_load(dep + 16 * tile, __ATOMIC_RELAXED, __HIP_MEMORY_SCOPE_AGENT) < 4u) { __builtin_amdgcn_s_sleep(2); if (++sp_ > (1u << 21)) break; } }
        int e = 0;
#pragma unroll 8
        for (int j = 1; j < NE; ++j) e += (tp[j] <= tile) ? 1 : 0;
        const int mt = tile - tp[e]; int valid = tp[40 + e] - mt * 256; valid = valid > 256 ? 256 : valid;
        u.pm = tile; u.pn = (e << SH) + pn; u.ax = e * ECAP + mt * 256; u.ax2 = valid; return true;
    }
    __device__ __forceinline__ int row_src(const Unit& u, int r) const { return tok[u.ax + (r < u.ax2 ? r : 0)]; }
};

__device__ __forceinline__ unsigned cvt_pk_bf16(float lo, float hi) { return pk2(lo, hi); }

#define PG8_ACC f32x4 (&acc)[2][2][4][2]
#define PG8_RSRC(ptr, bytes) __builtin_amdgcn_make_buffer_rsrc((void*)(ptr), (short)0, (int)(bytes), 0x00020000)
#ifndef WT_AUX
#define WT_AUX 16
#endif
#ifndef WT_SEL
#define WT_SEL 0x1f
#endif
template <int BIT> __device__ __forceinline__ void st16_wt(void* base, __amdgpu_buffer_rsrc_t rs, unsigned voff, unsigned soff, u32x4 v) {
    (void)rs;
    if constexpr ((WT_SEL >> BIT) & 1) { char* p_ = (char*)base + (size_t)voff + soff; asm volatile("global_store_dwordx4 %0, %1, off sc1\n\ts_nop 1" :: "v"(p_), "v"(v)); }
    else *(u32x4*)((char*)base + (size_t)voff + soff) = v; }

struct EpiG1 {
    static constexpr bool PERM = true, KEEP = false, SIGNAL = false;
    bf16_t *q, *k, *su, *sa, *sb;
    __device__ __forceinline__ bool keep(const Unit&) const { return false; }
    __device__ __forceinline__ void prefetch(const Unit&, int, unsigned (&pf)[4]) const { pf[0] = pf[1] = pf[2] = pf[3] = 0u; }
    __device__ __forceinline__ void operator()(PG8_ACC, const Unit& u, int wr, int wc, int fr, int fq) const {
        const bool isk = u.pn >= 4;
        const long long d_k = (const char*)k - (const char*)q;
        const __amdgpu_buffer_rsrc_t rs = PG8_RSRC((char*)q + (isk ? d_k : 0ll), (size_t)M * SBW * 2);
        const unsigned voff = (unsigned)(((u.pm * BM + wr * 64 + fr) * SBW + (u.pn & 3) * BM + wc * 32 + 8 * fq) * 2);
        const float sc = isk ? 1.0f : QSCALE;
#pragma unroll
        for (int ai = 0; ai < 2; ++ai)
#pragma unroll
            for (int m = 0; m < 4; ++m)
#pragma unroll
                for (int bj = 0; bj < 2; ++bj) { const f32x4 v0 = acc[ai][bj][m][0] * sc, v1 = acc[ai][bj][m][1] * sc;
                    u32x4 w; w.x = cvt_pk_bf16(v0[0], v0[1]); w.y = cvt_pk_bf16(v0[2], v0[3]); w.z = cvt_pk_bf16(v1[0], v1[1]); w.w = cvt_pk_bf16(v1[2], v1[3]);
                    st16_wt<0>((char*)q + (isk ? d_k : 0ll), rs, voff, (unsigned)(((ai * HALF + m * 16) * SBW + bj * HALF) * 2), w); }
    }
};
struct EpiGates {
    static constexpr bool PERM = true, KEEP = false, SIGNAL = false;
    bf16_t *sa  , *sb, *su;
    __device__ __forceinline__ bool keep(const Unit&) const { return false; }
    __device__ __forceinline__ void prefetch(const Unit&, int, unsigned (&pf)[4]) const { pf[0] = pf[1] = pf[2] = pf[3] = 0u; }
    __device__ __forceinline__ void operator()(PG8_ACC, const Unit& u, int wr, int wc, int fr, int fq) const {
        { int t_ = threadIdx.x; asm volatile("" : "+v"(t_)); fr = t_ & 15; fq = (t_ >> 4) & 3; }
        if (u.pn >= 16) {
            const int row0 = u.pm * BM + wr * 64 + fr, col0 = (u.pn - 16) * BM + wc * 32 + 8 * fq;
            const __amdgpu_buffer_rsrc_t rsu = PG8_RSRC(su, (size_t)M * SGW * 2);
#pragma unroll
            for (int ai = 0; ai < 2; ++ai)
#pragma unroll
                for (int m = 0; m < 4; ++m) {
#pragma unroll
                    for (int bj = 0; bj < 2; ++bj) { const f32x4 v0 = acc[ai][bj][m][0], v1 = acc[ai][bj][m][1];
                        const f32x2 a = gelu_pk((f32x2){v0[0], v0[1]}), b = gelu_pk((f32x2){v0[2], v0[3]}), c = gelu_pk((f32x2){v1[0], v1[1]}), d = gelu_pk((f32x2){v1[2], v1[3]});
                        u32x4 w; w.x = cvt_pk_bf16(a.x, a.y); w.y = cvt_pk_bf16(b.x, b.y); w.z = cvt_pk_bf16(c.x, c.y); w.w = cvt_pk_bf16(d.x, d.y);
                        st16_wt<1>(su, rsu, (unsigned)((row0 * SGW + col0) * 2), (unsigned)(((ai * HALF + m * 16) * SGW + bj * HALF) * 2), w); } }
        } else {
            const int row0 = u.pm * BM + wr * 64 + fr, col0 = u.pn * HALF + wc * 32 + 8 * fq;
            const __amdgpu_buffer_rsrc_t rsa = PG8_RSRC(sa, (size_t)M * GP * 2), rsb = PG8_RSRC(sb, (size_t)M * GP * 2);
            const unsigned voff = (unsigned)((row0 * GP + col0) * 2);
#pragma unroll
            for (int ai = 0; ai < 2; ++ai)
#pragma unroll
                for (int m = 0; m < 4; ++m) { const unsigned soff = (unsigned)(((ai * HALF + m * 16) * GP) * 2);
                    float rr[8], ss[8];
#pragma unroll
                    for (int n = 0; n < 2; ++n)
#pragma unroll
                        for (int j = 0; j < 4; ++j) { const float ea = __builtin_amdgcn_exp2f(-1.4426950408889634f * acc[ai][0][m][n][j]), eb = fminf(__builtin_amdgcn_exp2f(-1.4426950408889634f * acc[ai][1][m][n][j]), 1e30f);
                            ss[4 * n + j] = __builtin_amdgcn_rcpf(1.0f + eb); rr[4 * n + j] = (1.0f + eb) * __builtin_amdgcn_rcpf(1.0f + ea); }
                    u32x4 w; w.x = cvt_pk_bf16(rr[0], rr[1]); w.y = cvt_pk_bf16(rr[2], rr[3]); w.z = cvt_pk_bf16(rr[4], rr[5]); w.w = cvt_pk_bf16(rr[6], rr[7]);
                    st16_wt<1>(sa, rsa, voff, soff, w);
                    w.x = cvt_pk_bf16(ss[0], ss[1]); w.y = cvt_pk_bf16(ss[2], ss[3]); w.z = cvt_pk_bf16(ss[4], ss[5]); w.w = cvt_pk_bf16(ss[6], ss[7]);
                    st16_wt<1>(sb, rsb, voff, soff, w); }
        }
    }
};
struct EpiG2 {
    static constexpr bool PERM = true, KEEP = false, SIGNAL = false;
    bf16_t* vt;
    __device__ __forceinline__ bool keep(const Unit&) const { return false; }
    __device__ __forceinline__ void prefetch(const Unit&, int, unsigned (&pf)[4]) const { pf[0] = pf[1] = pf[2] = pf[3] = 0u; }
    __device__ __forceinline__ void operator()(PG8_ACC, const Unit& u, int wr, int wc, int fr, int fq) const {
        { int t_ = threadIdx.x; asm volatile("" : "+v"(t_)); fr = t_ & 15; fq = (t_ >> 4) & 3; }
        const int row0 = u.pm * BM + wr * 64 + fr, col0 = u.pn * BM + wc * 32 + 8 * fq; const bool gl = u.pm >= 4;
        const __amdgpu_buffer_rsrc_t rsv = PG8_RSRC(vt, (size_t)2048 * VTP * 2);
#pragma unroll
        for (int ai = 0; ai < 2; ++ai)
#pragma unroll
            for (int m = 0; m < 4; ++m) {
#pragma unroll
                for (int bj = 0; bj < 2; ++bj) { f32x4 v0 = acc[ai][bj][m][0], v1 = acc[ai][bj][m][1];
                    if (gl) { f32x2 a = gelu_pk((f32x2){v0[0], v0[1]}), b = gelu_pk((f32x2){v0[2], v0[3]}), c = gelu_pk((f32x2){v1[0], v1[1]}), d = gelu_pk((f32x2){v1[2], v1[3]});
                        v0 = (f32x4){a.x, a.y, b.x, b.y}; v1 = (f32x4){c.x, c.y, d.x, d.y}; }
                    u32x4 w; w.x = cvt_pk_bf16(v0[0], v0[1]); w.y = cvt_pk_bf16(v0[2], v0[3]); w.z = cvt_pk_bf16(v1[0], v1[1]); w.w = cvt_pk_bf16(v1[2], v1[3]);
                    st16_wt<2>(vt, rsv, (unsigned)((row0 * VTP + col0) * 2), (unsigned)(((ai * HALF + m * 16) * VTP + bj * HALF) * 2), w); } }
    }
};
struct EpiGate {
    static constexpr bool PERM = true, KEEP = true, SIGNAL = false;
    const bf16_t *sa  , *sb; bf16_t* O;
    __device__ __forceinline__ bool keep(const Unit& u) const { return u.ax == 0; }
    __device__ __forceinline__ void prefetch(const Unit&, int, unsigned (&pf)[4]) const { pf[0] = pf[1] = pf[2] = pf[3] = 0u; }
    __device__ __forceinline__ void operator()(PG8_ACC, const Unit& u, int wr, int wc, int fr, int fq) const {
        { int t_ = threadIdx.x; asm volatile("" : "+v"(t_)); fr = t_ & 15; fq = (t_ >> 4) & 3; }
        const int pm = u.ax ? u.pm - 64 : u.pm, pn = u.ax ? u.pn - 8 : u.pn;
        const unsigned loff = (unsigned)(((wr * 64 + fr) * GP + wc * 32 + 8 * fq) * 2);
        const size_t uoff = ((size_t)pm * BM * GP + (size_t)pn * BM) * 2;
        const long long d_sb = (const char*)sb - (const char*)sa;
        const char* gp = (const char*)sa + (u.ax ? d_sb : 0ll) + uoff;
#pragma unroll
        for (int ai = 0; ai < 2; ++ai) {
            u32x4 gv[4][2];
#pragma unroll
            for (int m = 0; m < 4; ++m)
#pragma unroll
                for (int bj = 0; bj < 2; ++bj) gv[m][bj] = *(const u32x4*)(gp + (size_t)(((ai * HALF + m * 16) * GP + bj * HALF) * 2) + loff);
            if (u.ax == 0) {
#pragma unroll
                for (int m = 0; m < 4; ++m)
#pragma unroll
                    for (int bj = 0; bj < 2; ++bj) { const u32x4 g4 = gv[m][bj];
                        const float s[8] = {bflo(g4.x), bfhi(g4.x), bflo(g4.y), bfhi(g4.y), bflo(g4.z), bfhi(g4.z), bflo(g4.w), bfhi(g4.w)};
#pragma unroll
                        for (int j = 0; j < 4; ++j) { acc[ai][bj][m][0][j] *= s[j]; acc[ai][bj][m][1][j] *= s[4 + j]; } }
            } else {
                const __amdgpu_buffer_rsrc_t rso = PG8_RSRC(O, (size_t)M * GP * 2);
#pragma unroll
                for (int m = 0; m < 4; ++m)
#pragma unroll
                    for (int bj = 0; bj < 2; ++bj) { const u32x4 g4 = gv[m][bj];
                        const float s[8] = {bflo(g4.x), bfhi(g4.x), bflo(g4.y), bfhi(g4.y), bflo(g4.z), bfhi(g4.z), bflo(g4.w), bfhi(g4.w)};
                        f32x4 v0 = acc[ai][bj][m][0], v1 = acc[ai][bj][m][1];
#pragma unroll
                        for (int j = 0; j < 4; ++j) { v0[j] *= s[j]; v1[j] *= s[4 + j]; }
                        u32x4 w; w.x = cvt_pk_bf16(v0[0], v0[1]); w.y = cvt_pk_bf16(v0[2], v0[3]); w.z = cvt_pk_bf16(v1[0], v1[1]); w.w = cvt_pk_bf16(v1[2], v1[3]);
                        st16_wt<3>(O, rso, (unsigned)uoff + loff, (unsigned)(((ai * HALF + m * 16) * GP + bj * HALF) * 2), w); }
            }
            asm volatile("" ::: "memory");
        }
    }
};
struct EpiY {
    static constexpr bool PERM = true, KEEP = false, SIGNAL = false;
    bf16_t* O;
    __device__ __forceinline__ bool keep(const Unit&) const { return false; }
    __device__ __forceinline__ void prefetch(const Unit&, int, unsigned (&pf)[4]) const { pf[0] = pf[1] = pf[2] = pf[3] = 0u; }
    __device__ __forceinline__ void operator()(PG8_ACC, const Unit& u, int wr, int wc, int fr, int fq) const {
        const __amdgpu_buffer_rsrc_t rs = PG8_RSRC(O, (size_t)M * GP * 2);
        const unsigned voff = (unsigned)(((u.pm * BM + wr * 64 + fr) * GP + u.pn * BM + wc * 32 + 8 * fq) * 2);
#pragma unroll
        for (int ai = 0; ai < 2; ++ai)
#pragma unroll
            for (int m = 0; m < 4; ++m)
#pragma unroll
                for (int bj = 0; bj < 2; ++bj) { const f32x4 v0 = acc[ai][bj][m][0], v1 = acc[ai][bj][m][1];
                    u32x4 w; w.x = cvt_pk_bf16(v0[0], v0[1]); w.y = cvt_pk_bf16(v0[2], v0[3]); w.z = cvt_pk_bf16(v1[0], v1[1]); w.w = cvt_pk_bf16(v1[2], v1[3]);
                    st16_wt<4>(O, rs, voff, (unsigned)(((ai * HALF + m * 16) * GP + bj * HALF) * 2), w); }
    }
};
struct EpiGU {
    static constexpr bool PERM = true, KEEP = false, SIGNAL = true;
    unsigned char* hb;
    unsigned* tilecnt;
    __device__ __forceinline__ void signal(const Unit& u) const { __hip_atomic_fetch_add(tilecnt + 16 * u.pm, 1u, __ATOMIC_RELAXED, __HIP_MEMORY_SCOPE_AGENT); }
    __device__ __forceinline__ bool keep(const Unit&) const { return false; }
    __device__ __forceinline__ void prefetch(const Unit&, int, unsigned (&pf)[4]) const { pf[0] = pf[1] = pf[2] = pf[3] = 0u; }
    __device__ __forceinline__ void operator()(PG8_ACC, const Unit& u, int wr, int wc, int fr, int fq) const {
        { int t_ = threadIdx.x; asm volatile("" : "+v"(t_)); fr = t_ & 15; fq = (t_ >> 4) & 3; }
        const int odd = fq & 1;
        const int row0 = u.pm * BM + wr * 64 + fr, col0 = (u.pn & 3) * HALF + wc * 32 + 8 * (fq & 2);
#pragma unroll
        for (int ai = 0; ai < 2; ++ai)
#pragma unroll
            for (int mp = 0; mp < 2; ++mp) {
                unsigned we[2], wo[2];
#pragma unroll
                for (int q = 0; q < 2; ++q) { const int m = 2 * mp + q;
                    f32x4 g0 = acc[ai][0][m][0], g1 = acc[ai][0][m][1]; const f32x4 u0 = acc[ai][1][m][0], u1 = acc[ai][1][m][1];
#pragma unroll
                    for (int j = 0; j < 4; ++j) { g0[j] = g0[j] * sigmoidf_(g0[j]) * u0[j]; g1[j] = g1[j] * sigmoidf_(g1[j]) * u1[j]; }
                    const unsigned x0 = pk4_fp8(g0[0], g0[1], g0[2], g0[3]), x1 = pk4_fp8(g1[0], g1[1], g1[2], g1[3]);
                    if (q == 0) { we[0] = x0; we[1] = x1; } else { wo[0] = x0; wo[1] = x1; } }
                const auto s0 = __builtin_amdgcn_permlane16_swap(we[0], wo[0], false, false);
                const auto s1 = __builtin_amdgcn_permlane16_swap(we[1], wo[1], false, false);
                u32x4 w; w.x = s0[0]; w.y = s1[0]; w.z = s0[1]; w.w = s1[1];
                *(u32x4*)(hb + (size_t)(row0 + ai * HALF + (2 * mp + odd) * 16) * DE + col0) = w; }
    }
};
struct EpiDown {
    static constexpr bool PERM = true, KEEP = false, SIGNAL = false;
    unsigned char* ys;
    __device__ __forceinline__ bool keep(const Unit&) const { return false; }
    __device__ __forceinline__ void prefetch(const Unit&, int, unsigned (&pf)[4]) const { pf[0] = pf[1] = pf[2] = pf[3] = 0u; }
    __device__ __forceinline__ void operator()(PG8_ACC, const Unit& u, int wr, int wc, int fr, int fq) const {
        { int t_ = threadIdx.x; asm volatile("" : "+v"(t_)); fr = t_ & 15; fq = (t_ >> 4) & 3; }
        const int odd = fq & 1;
        unsigned char* rowp0 = ys + (size_t)(u.pm * BM + wr * 64 + fr) * DM + (u.pn & 7) * BM + wc * 32 + 8 * (fq & 2) + odd * HALF;
#pragma unroll
        for (int ai = 0; ai < 2; ++ai)
#pragma unroll
            for (int m = 0; m < 4; ++m) {
                const f32x4 a0 = acc[ai][0][m][0], a1 = acc[ai][0][m][1], b0 = acc[ai][1][m][0], b1 = acc[ai][1][m][1];
                const unsigned wa0 = pk4_fp8(a0[0], a0[1], a0[2], a0[3]), wa1 = pk4_fp8(a1[0], a1[1], a1[2], a1[3]), wb0 = pk4_fp8(b0[0], b0[1], b0[2], b0[3]), wb1 = pk4_fp8(b1[0], b1[1], b1[2], b1[3]);
                const auto s0 = __builtin_amdgcn_permlane16_swap(wa0, wb0, false, false);
                const auto s1 = __builtin_amdgcn_permlane16_swap(wa1, wb1, false, false);
                u32x4 w; w.x = s0[0]; w.y = s1[0]; w.z = s0[1]; w.w = s1[1];
                *(u32x4*)(rowp0 + (size_t)(ai * HALF + m * 16) * DM) = w; }
    }
};

typedef int v8i32 __attribute__((ext_vector_type(8)));
template <class Epi, class Sched, bool ALIGN_EPI, bool FP8 = false>
__device__ __forceinline__ void gemm_phase(LAS unsigned char* lds, const Gemm g, const Sched& S, const Epi& E) {
    const int tid = threadIdx.x, wid = __builtin_amdgcn_readfirstlane(tid >> 6), lane = tid & 63, wr = wid >> 2, wc = wid & 3, fr = lane & 15, fq = lane >> 4;
    const int K = g.K, nt = K / BK, LA = g.lda ? g.lda : g.K, LB = g.ldb ? g.ldb : g.K;
    unsigned voffA[2], voffB[2]; int stR[2], stC[2];
#pragma unroll
    for (int i = 0; i < 2; ++i) { int R, C; if constexpr (FP8) stage_rc8(tid * 16 + i * 8192, R, C); else stage_rc(tid * 16 + i * 8192, R, C); const int Rb = Epi::PERM ? ((R & ~31) + perm32(R & 31)) : R;
        stR[i] = R; stC[i] = C; voffA[i] = (unsigned)(R * LA + C) * 2u; voffB[i] = (unsigned)(Rb * LB + C) * 2u; }
    const size_t kstep = (size_t)(BK * 2);
    const size_t hstep = (size_t)HALF * LB * 2, hstepA = (size_t)HALF * LA * 2;
    const size_t tstep = 2 * hstep, tstepA = 2 * hstepA;
    const unsigned ldsw = (unsigned)wid * 1024u;
    const int aoff = FP8 ? lds_byte8(wr * 64 + fr, fq * 16) : lds_byte(wr * 64 + fr, fq * 8), boff = FP8 ? lds_byte8(wc * 32 + fr, fq * 16) : lds_byte(wc * 32 + fr, fq * 8);
#define PG8_SA(b, h) (((b) * 2 + (h)) * HTB)
#define PG8_SB(b, h) ((4 + (b) * 2 + (h)) * HTB)
#define PG8_STAGE(bufoff, gbase, voff) do { _Pragma("unroll") for (int _i = 0; _i < 2; ++_i) \
        __builtin_amdgcn_global_load_lds((const unsigned*)((const char*)(gbase) + (voff)[_i]), (LAS unsigned*)(lds + (bufoff) + ldsw + _i * 8192), 16, 0, 0); } while (0)
#define PG8_STAGE_A(bufoff, ubase, vg, h, kb) do { if constexpr (Sched::GATHER) PG8_STAGE(bufoff, (const char*)g.A + (kb), (vg)[h]); else PG8_STAGE(bufoff, (ubase) + (h) * hstepA + (kb), voffA); } while (0)
#define PG8_LD16(off) (*(const LAS bf16x8*)(lds + (off)))
#define PG8_CAT8(lo, hi) __builtin_bit_cast(v8i32, __builtin_shufflevector((lo), (hi), 0, 1, 2, 3, 4, 5, 6, 7, 8, 9, 10, 11, 12, 13, 14, 15))
#define PG8_LDA(dst, b, h) do { if constexpr (FP8) { int ab_ = aoff; asm volatile("" : "+v"(ab_)); ab_ += PG8_SA(b, h);   \
            const int ab2_ = ab_ ^ 16;   \
            _Pragma("unroll") for (int m = 0; m < 4; ++m) dst##8[m] = PG8_CAT8(PG8_LD16(ab_ + m * 2048), PG8_LD16(ab2_ + m * 2048)); } \
        else { _Pragma("unroll") for (int m = 0; m < 4; ++m) _Pragma("unroll") for (int k = 0; k < 2; ++k) dst[m][k] = PG8_LD16(PG8_SA(b, h) + aoff + m * 2048 + k * 1024); } } while (0)
#define PG8_LDB(dst, b, h) do { if constexpr (FP8) { int bb_ = boff; asm volatile("" : "+v"(bb_)); bb_ += PG8_SB(b, h); \
            const int bb2_ = bb_ ^ 16; \
            _Pragma("unroll") for (int n = 0; n < 2; ++n) dst##8[n] = PG8_CAT8(PG8_LD16(bb_ + n * 2048), PG8_LD16(bb2_ + n * 2048)); } \
        else { _Pragma("unroll") for (int n = 0; n < 2; ++n) _Pragma("unroll") for (int k = 0; k < 2; ++k) dst[n][k] = PG8_LD16(PG8_SB(b, h) + boff + n * 2048 + k * 1024); } } while (0)
#define PG8_MMA(ai, bj, At, Bt) do { __builtin_amdgcn_s_setprio(1); \
        if constexpr (FP8) { _Pragma("unroll") for (int m = 0; m < 4; ++m) _Pragma("unroll") for (int n = 0; n < 2; ++n) \
            acc[ai][bj][m][n] = __builtin_amdgcn_mfma_scale_f32_16x16x128_f8f6f4(Bt##8[n], At##8[m], acc[ai][bj][m][n], 0, 0, 0, 0x79797979, 0, 0x7f7f7f7f); } \
        else { _Pragma("unroll") for (int m = 0; m < 4; ++m) _Pragma("unroll") for (int n = 0; n < 2; ++n) _Pragma("unroll") for (int k = 0; k < 2; ++k) \
            acc[ai][bj][m][n] = __builtin_amdgcn_mfma_f32_16x16x32_bf16(Bt[n][k], At[m][k], acc[ai][bj][m][n], 0, 0, 0); } \
        __builtin_amdgcn_s_setprio(0); \
        if constexpr (FP8) asm volatile("" : "+v"(acc[ai][bj][0][0]), "+v"(acc[ai][bj][0][1]), "+v"(acc[ai][bj][1][0]), "+v"(acc[ai][bj][1][1]), "+v"(acc[ai][bj][2][0]), "+v"(acc[ai][bj][2][1]), "+v"(acc[ai][bj][3][0]), "+v"(acc[ai][bj][3][1])); \
        } while (0)
#define PG8_WAIT_V(n) asm volatile("s_waitcnt vmcnt(" #n ")" ::: "memory")
#define PG8_WAIT_L(n) asm volatile("s_waitcnt lgkmcnt(" #n ")" ::: "memory")
#define PG8_BAR __builtin_amdgcn_s_barrier()
#define PG8_SCHED __builtin_amdgcn_sched_barrier(0)
#define PG8_PIN do { } while (0)
#define PG8_UNI(u) do { (u).pm = __builtin_amdgcn_readfirstlane((u).pm); (u).pn = __builtin_amdgcn_readfirstlane((u).pn); (u).ax = __builtin_amdgcn_readfirstlane((u).ax); (u).ax2 = __builtin_amdgcn_readfirstlane((u).ax2); } while (0)
#define PG8_FILL(v, u) do { _Pragma("unroll") for (int _h = 0; _h < 2; ++_h) _Pragma("unroll") for (int _i = 0; _i < 2; ++_i) \
        (v)[_h][_i] = (unsigned)(S.row_src((u), _h * HALF + stR[_i]) * LA + stC[_i]) * 2u; } while (0)
    Unit cur, nxt; int ui = 0;
    if (!S.next(0, cur)) return;
    PG8_UNI(cur);
    f32x4 acc[2][2][4][2];
#pragma unroll
    for (int a = 0; a < 2; ++a)
#pragma unroll
        for (int b = 0; b < 2; ++b)
#pragma unroll
            for (int m = 0; m < 4; ++m)
#pragma unroll
                for (int n = 0; n < 2; ++n) acc[a][b][m][n] = (f32x4){0.f, 0.f, 0.f, 0.f};
    bf16x8 At[4][2], B0[2][2], B1[2][2];
    v8i32 At8[4], B08[2], B18[2];
    unsigned vAc[2][2] = {{0u, 0u}, {0u, 0u}}, vAn[2][2] = {{0u, 0u}, {0u, 0u}}, vA2[2][2] = {{0u, 0u}, {0u, 0u}};
    if constexpr (Sched::GATHER) PG8_FILL(vAc, cur);
    const char* cA = (const char*)g.A + (Sched::GATHER ? (size_t)0 : (size_t)cur.pm * tstepA); const char* cB = (const char*)g.Bt + (size_t)cur.pn * tstep;
    PG8_STAGE(PG8_SB(0, 0), cB, voffB); PG8_STAGE(PG8_SB(0, 1), cB + hstep, voffB); PG8_STAGE_A(PG8_SA(0, 0), cA, vAc, 0, (size_t)0); PG8_STAGE_A(PG8_SA(0, 1), cA, vAc, 1, (size_t)0);
    if (wr == 1) PG8_BAR;
    PG8_WAIT_V(2); PG8_BAR;
    PG8_STAGE(PG8_SB(1, 0), cB + kstep, voffB); PG8_STAGE_A(PG8_SA(1, 0), cA, vAc, 0, kstep); PG8_STAGE(PG8_SB(1, 1), cB + hstep + kstep, voffB);
    PG8_WAIT_V(6); PG8_BAR;
    GP_ACC(29);
    for (;;) {
        bool has_next = S.next(ui + 1, nxt);
        has_next = __builtin_amdgcn_readfirstlane((int)has_next) != 0;
        if (has_next) { PG8_UNI(nxt); if constexpr (Sched::GATHER) PG8_FILL(vAn, nxt); }
        const char* nA = (has_next && !Sched::GATHER) ? (const char*)g.A + (size_t)nxt.pm * tstepA : cA; const char* nB = has_next ? (const char*)g.Bt + (size_t)nxt.pn * tstep : cB;
        for (int t = 0; t < nt; t += 2) {
            if constexpr (FP8) asm volatile("" : "+v"(voffA[0]), "+v"(voffA[1]), "+v"(voffB[0]), "+v"(voffB[1]));
            const bool last = (t == nt - 2);
            const size_t k1 = (size_t)(t + 1) * kstep;
            const size_t k2 = last ? (size_t)0 : (size_t)(t + 2) * kstep, k3 = k2 + kstep;
            const char* a2 = last ? nA : cA; const char* b2 = (last ? nB : cB) + k2; const char* b3 = b2 + kstep;
            if constexpr (Sched::GATHER) {
#pragma unroll
                for (int h = 0; h < 2; ++h)
#pragma unroll
                    for (int i = 0; i < 2; ++i) vA2[h][i] = (last && has_next) ? vAn[h][i] : vAc[h][i];
            }
            PG8_LDB(B0, 0, 0); PG8_LDB(B1, 0, 1); PG8_SCHED; PG8_LDA(At, 0, 0); PG8_STAGE_A(PG8_SA(1, 1), cA, vAc, 1, k1);
            PG8_WAIT_V(8); PG8_WAIT_L(0); PG8_BAR; PG8_PIN; PG8_MMA(0, 0, At, B0); PG8_MMA(0, 1, At, B1); PG8_PIN; PG8_BAR; PG8_SCHED;
            PG8_LDA(At, 0, 1); PG8_STAGE(PG8_SB(0, 0), b2, voffB); PG8_STAGE(PG8_SB(0, 1), b2 + hstep, voffB); PG8_STAGE_A(PG8_SA(0, 0), a2, vA2, 0, k2);
            PG8_WAIT_V(8); PG8_WAIT_L(0); PG8_BAR; PG8_PIN; PG8_MMA(1, 0, At, B0); PG8_MMA(1, 1, At, B1); PG8_PIN; PG8_BAR; PG8_SCHED;
            PG8_LDB(B0, 1, 0); PG8_LDB(B1, 1, 1); PG8_SCHED; PG8_LDA(At, 1, 0); PG8_STAGE_A(PG8_SA(0, 1), a2, vA2, 1, k2);
            PG8_WAIT_V(8); PG8_WAIT_L(0); PG8_BAR; PG8_PIN; PG8_MMA(0, 0, At, B0); PG8_MMA(0, 1, At, B1); PG8_PIN; PG8_BAR; PG8_SCHED;
            PG8_LDA(At, 1, 1); PG8_STAGE(PG8_SB(1, 0), b3, voffB); PG8_STAGE(PG8_SB(1, 1), b3 + hstep, voffB); PG8_STAGE_A(PG8_SA(1, 0), a2, vA2, 0, k3);
            PG8_WAIT_V(8); PG8_WAIT_L(0); PG8_BAR; PG8_PIN; PG8_MMA(1, 0, At, B0); PG8_MMA(1, 1, At, B1); PG8_PIN; PG8_BAR; PG8_SCHED;
        }
        GP_ACC(26);
        if constexpr (ALIGN_EPI) { if (wr == 0) PG8_BAR; }
        E(acc, cur, wr, wc, fr, fq);
        if constexpr (Epi::SIGNAL) {
            PG8_WAIT_V(0); PG8_BAR;
            if (tid == 0) E.signal(cur); }
        if (GP_PROBE == 2) PG8_WAIT_V(0);
        GP_ACC(27);
        if constexpr (GP_PROBE && __is_same(Epi, GP_PROBE_EPI)) { if (tid == 0) ((volatile LAS unsigned long long*)(lds + 131072 + 1024))[28] += 100ull; }
        if (!has_next) break;
        if (!(Epi::KEEP && E.keep(cur))) {
#pragma unroll
            for (int a = 0; a < 2; ++a)
#pragma unroll
                for (int b = 0; b < 2; ++b)
#pragma unroll
                    for (int m = 0; m < 4; ++m)
#pragma unroll
                        for (int n = 0; n < 2; ++n) acc[a][b][m][n] = (f32x4){0.f, 0.f, 0.f, 0.f};
        }
        cur = nxt; cA = nA; cB = nB; ++ui;
        if constexpr (Sched::GATHER) {
#pragma unroll
            for (int h = 0; h < 2; ++h)
#pragma unroll
                for (int i = 0; i < 2; ++i) vAc[h][i] = vAn[h][i];
        }
        if constexpr (ALIGN_EPI) { if (wr == 1) PG8_BAR; }
    }
    PG8_WAIT_V(0);
    if constexpr (!ALIGN_EPI) { if (wr == 0) PG8_BAR; }
    PG8_BAR;
#undef PG8_SA
#undef PG8_SB
#undef PG8_STAGE
#undef PG8_STAGE_A
#undef PG8_LDA
#undef PG8_LDB
#undef PG8_MMA
#undef PG8_CAT8
#undef PG8_LD16
#undef PG8_WAIT_V
#undef PG8_WAIT_L
#undef PG8_BAR
#undef PG8_SCHED
#undef PG8_PIN
#undef PG8_UNI
#undef PG8_FILL
}
}

#define XB_TMO      128
#define XB_XCNT(j)  (256  + 64 * (j))
#define XB_XSUB(j)  (1280 + 64 * (j))
#define XB_XGEN(j)  (2304 + 64 * (j))
#define XB_TOP      3328
#define XB_TOPGEN   3392
#define XCD_BAR_WORDS 3456
#define XB_SPIN_CAP (1u << 18)
__device__ __forceinline__ unsigned xb_ld(unsigned* p)              { return __hip_atomic_load(p, __ATOMIC_RELAXED, __HIP_MEMORY_SCOPE_AGENT); }
__device__ __forceinline__ unsigned xb_add(unsigned* p, unsigned v) { return __hip_atomic_fetch_add(p, v, __ATOMIC_RELAXED, __HIP_MEMORY_SCOPE_AGENT); }
__device__ __forceinline__ unsigned xb_xcc_id() { return (unsigned)__builtin_amdgcn_s_getreg((3 << 11) | 20) & 0xFu; }
#define XB_SPIN(cond, bar) do { unsigned _sp = 0; while (cond) { __builtin_amdgcn_s_sleep(1); \
    if ((++_sp & 255u) == 0u) { if (xb_ld(&(bar)[XB_TMO])) break; if (_sp > XB_SPIN_CAP) { atomicAdd(&(bar)[XB_TMO], 1u); break; } } } } while (0)
struct XcdBarrier { unsigned* bar; unsigned x; volatile LAS unsigned* st; };
__device__ __forceinline__ XcdBarrier xcd_barrier_post(unsigned* bar, volatile LAS unsigned* st) {
    XcdBarrier b; b.bar = bar; b.x = xb_xcc_id(); b.st = st;
    if (threadIdx.x == 0) st[2] = xb_add(&bar[XB_XCNT(b.x)], 1u);
    return b;
}
#ifndef XL_DISABLE
#define XL_DISABLE 0
#endif
__device__ __forceinline__ void xcd_barrier_complete(unsigned* bar, unsigned x, unsigned& nloc, unsigned& nx, unsigned& all32) {
    const unsigned G = gridDim.x * gridDim.y * gridDim.z;
    unsigned sum, cnt, mine, n32, sp = 0u;
    for (;;) {
        sum = 0u; cnt = 0u; mine = 0u; n32 = 0u;
#pragma unroll
        for (unsigned j = 0; j < 16; ++j) { const unsigned c = xb_ld(&bar[XB_XCNT(j)]); sum += c; cnt += (c > 0u) ? 1u : 0u; n32 += (j < 8u && c == 32u) ? 1u : 0u; mine = (j == x) ? c : mine; }
        if (sum == G) break;
        __builtin_amdgcn_s_sleep(1);
        if ((++sp & 255u) == 0u) { if (xb_ld(&bar[XB_TMO])) break; if (sp > XB_SPIN_CAP) { atomicAdd(&bar[XB_TMO], 1u); break; } }
    }
    nloc = mine > 0u ? mine : 1u; nx = cnt > 0u ? cnt : 1u; all32 = (!XL_DISABLE && sum == G && G == 256u && cnt == 8u && n32 == 8u) ? 1u : 0u;
}
__device__ __forceinline__ void xcd_barrier(const XcdBarrier& b) {
    asm volatile("s_waitcnt vmcnt(0)" ::: "memory");
    __syncthreads();
    if (threadIdx.x == 0) {
        unsigned* bar = b.bar;
        __builtin_amdgcn_s_waitcnt(0);
        unsigned nloc = b.st[0], nx = b.st[1];
        if (nloc == 0u) { unsigned a32; xcd_barrier_complete(bar, b.x, nloc, nx, a32); b.st[0] = nloc; b.st[1] = nx; b.st[3] = a32; }
        const unsigned old = xb_add(&bar[XB_XSUB(b.x)], 1u);
        const unsigned gen = old / nloc;
        if (old + 1u == (gen + 1u) * nloc) {
            __builtin_amdgcn_fence(__ATOMIC_RELEASE, "agent");
            asm volatile("s_waitcnt vmcnt(0)" ::: "memory");
            const unsigned og = xb_add(&bar[XB_TOP], 1u);
            const unsigned tgt = (og / nx + 1u) * nx;
            if (og + 1u != tgt) XB_SPIN(xb_ld(&bar[XB_TOP]) < tgt, bar);
            xb_add(&bar[XB_XGEN(b.x)], 1u);
            __builtin_amdgcn_fence(__ATOMIC_ACQUIRE, "agent");
            asm volatile("s_waitcnt vmcnt(0)" ::: "memory");
        } else {
            XB_SPIN(xb_ld(&bar[XB_XGEN(b.x)]) == gen, bar);
            __builtin_amdgcn_fence(__ATOMIC_ACQUIRE, "agent");
            asm volatile("s_waitcnt vmcnt(0)" ::: "memory");
        }
    }
    __syncthreads();
}

__device__ __forceinline__ void xcd_local_barrier(const XcdBarrier& b, unsigned* waitp = nullptr, unsigned waitv = 0u, unsigned* flagp = nullptr) {
    asm volatile("s_waitcnt vmcnt(0)" ::: "memory");
    __syncthreads();
    if (threadIdx.x == 0) {
        unsigned* bar = b.bar;
        __builtin_amdgcn_s_waitcnt(0);
        const unsigned nloc = b.st[0];
        const unsigned old = xb_add(&bar[XB_XSUB(b.x)], 1u);
        const unsigned gen = old / nloc;
        if (old + 1u == (gen + 1u) * nloc) { if (flagp) xb_add(flagp, 1u); xb_add(&bar[XB_XGEN(b.x)], 1u); }
        else XB_SPIN(xb_ld(&bar[XB_XGEN(b.x)]) == gen, bar);
        if (waitp) XB_SPIN(xb_ld(waitp) < waitv, bar);
        __builtin_amdgcn_fence(__ATOMIC_ACQUIRE, "agent");
        asm volatile("s_waitcnt vmcnt(0)" ::: "memory");
    }
    __syncthreads();
}

__device__ __forceinline__ void transpose_item(const float* W, int K, int N, bf16_t* WT, int k0, int n0, int dst_off, LAS float* scr, int lane, int ldw = 0) {
    if (ldw == 0) ldw = K;
    float tv[32];
#pragma unroll
    for (int i = 0; i < 32; ++i) { const int kk = 2 * i + (lane >> 5); tv[i] = __builtin_nontemporal_load(&W[(size_t)(k0 + kk) * N + n0 + (lane & 31)]); }
#pragma unroll
    for (int i = 0; i < 32; ++i) { const int kk = 2 * i + (lane >> 5); scr[kk * 33 + (lane & 31)] = tv[i]; }
    LDS_WAIT(); asm volatile("" ::: "memory");
    const int c = lane & 7;
#pragma unroll
    for (int j = 0; j < 4; ++j) { const int n = (lane >> 3) + 8 * j; const LAS float* s = scr + (8 * c) * 33 + n;
        u32x4 o; o.x = pk2(s[0 * 33], s[1 * 33]); o.y = pk2(s[2 * 33], s[3 * 33]); o.z = pk2(s[4 * 33], s[5 * 33]); o.w = pk2(s[6 * 33], s[7 * 33]);
        st16u_sc1(WT + (size_t)(dst_off + n0 + n) * ldw + k0 + 8 * c, o); }
    LDS_WAIT(); asm volatile("" ::: "memory");
}
__device__ __forceinline__ void transpose_item_fp8(const float* W, int K, int N, unsigned char* WT, int k0, int n0, int dst_off, LAS float* scr, int lane) {
    float tv[32];
#pragma unroll
    for (int i = 0; i < 32; ++i) { const int kk = 2 * i + (lane >> 5); tv[i] = __builtin_nontemporal_load(&W[(size_t)(k0 + kk) * N + n0 + (lane & 31)]); }
#pragma unroll
    for (int i = 0; i < 32; ++i) { const int kk = 2 * i + (lane >> 5); scr[kk * 33 + (lane & 31)] = tv[i]; }
    LDS_WAIT(); asm volatile("" ::: "memory");
    const int c = lane & 7;
#pragma unroll
    for (int j = 0; j < 4; ++j) { const int n = (lane >> 3) + 8 * j; const LAS float* s = scr + (8 * c) * 33 + n;
        u32x2 o; o.x = pk4_fp8(s[0 * 33] * 64.f, s[1 * 33] * 64.f, s[2 * 33] * 64.f, s[3 * 33] * 64.f); o.y = pk4_fp8(s[4 * 33] * 64.f, s[5 * 33] * 64.f, s[6 * 33] * 64.f, s[7 * 33] * 64.f);
        *(u32x2*)(WT + (size_t)(dst_off + n0 + n) * K + k0 + 8 * c) = o; }
    LDS_WAIT(); asm volatile("" ::: "memory");
}
__device__ __forceinline__ void transpose_item_fp8_wt(const float* W, int K, int N, unsigned char* WT, int k0, int n0, int dst_off, LAS float* scr, int lane) {
    float tv[32];
#pragma unroll
    for (int i = 0; i < 32; ++i) { const int kk = 2 * i + (lane >> 5); tv[i] = __builtin_nontemporal_load(&W[(size_t)(k0 + kk) * N + n0 + (lane & 31)]); }
#pragma unroll
    for (int i = 0; i < 32; ++i) { const int kk = 2 * i + (lane >> 5); scr[kk * 33 + (lane & 31)] = tv[i]; }
    LDS_WAIT(); asm volatile("" ::: "memory");
    const int c = lane & 3;
#pragma unroll
    for (int j = 0; j < 2; ++j) { const int n = (lane >> 2) + 16 * j; const LAS float* s = scr + (16 * c) * 33 + n;
        u32x4 o; o.x = pk4_fp8(s[0 * 33] * 64.f, s[1 * 33] * 64.f, s[2 * 33] * 64.f, s[3 * 33] * 64.f); o.y = pk4_fp8(s[4 * 33] * 64.f, s[5 * 33] * 64.f, s[6 * 33] * 64.f, s[7 * 33] * 64.f);
        o.z = pk4_fp8(s[8 * 33] * 64.f, s[9 * 33] * 64.f, s[10 * 33] * 64.f, s[11 * 33] * 64.f); o.w = pk4_fp8(s[12 * 33] * 64.f, s[13 * 33] * 64.f, s[14 * 33] * 64.f, s[15 * 33] * 64.f);
        st16u_sc1(WT + (size_t)(dst_off + n0 + n) * K + k0 + 16 * c, o); }
    LDS_WAIT(); asm volatile("" ::: "memory");
}
__device__ __forceinline__ bool win_is_bf16(int n0) { return n0 < 2048; }
__device__ __forceinline__ int win_dst(int n0) { return n0; }
__device__ __forceinline__ int win8_dst(int n0) {
    if (n0 < 3072) return 5120 + (n0 - 2048);
    if (n0 < 4096) return 4096 + (n0 - 3072);
    if (n0 < 5120) return 6144 + (n0 - 4096);
    const int g = n0 - 5120, c = g & 2047;
    return 256 * (c >> 7) + (c & 127) + (g >= 2048 ? 128 : 0);
}

#ifndef DBG_COUNT
#define DBG_COUNT 0
#endif
__device__ __forceinline__ int crow(int r, int hi) { return (r & 3) + 8 * (r >> 2) + 4 * hi; }
__device__ __forceinline__ int kperm(int i) { return (i & 0x13) | ((i & 8) >> 1) | ((i & 4) << 1); }
__device__ __forceinline__ void sb_dma_k(const bf16_t* Kb, size_t tokrow0, int h, LAS unsigned char* kt, int lane) {
    const int rsub = lane >> 4, p = lane & 15;
#pragma unroll
    for (int i = 0; i < 8; ++i) { const int row = 4 * i + rsub, c = p ^ (row & 15);
        __builtin_amdgcn_global_load_lds((const unsigned*)(Kb + (tokrow0 + row) * SBW + h * HD + c * 8), (LAS unsigned*)(kt + i * 1024), 16, 0, 0); }
}
__device__ __forceinline__ void sb_dma_v(const bf16_t* VT, size_t tokcol0, int h, LAS unsigned char* vt, int lane) {
    const int dsub = lane >> 2, p = lane & 3;
#pragma unroll
    for (int i = 0; i < 8; ++i) { const int d = 16 * i + dsub, c = p ^ ((d >> 2) & 3);
        __builtin_amdgcn_global_load_lds((const unsigned*)(VT + (size_t)(h * HD + d) * VTP + tokcol0 + c * 8), (LAS unsigned*)(vt + i * 1024), 16, 0, 0); }
}
#ifndef ATT_PROBE
#define ATT_PROBE 0
#endif
#define ATT_ACC(slot) do { if (ATT_PROBE && threadIdx.x == 0) { volatile LAS unsigned long long* t_ = (volatile LAS unsigned long long*)(wsl + 131072 + 1024); const unsigned long long n_ = __builtin_amdgcn_s_memrealtime(); t_[slot] += n_ - t_[18]; t_[18] = n_; } } while (0)
__device__ __forceinline__ void sb_attn_unit(int b, int h, int qb, const bf16_t* Q, const bf16_t* Kb, const bf16_t* VT, bf16_t* Oa, LAS unsigned char* wsl  , int lane, unsigned* dbg_cnt) {
    const int r32 = lane & 31, hi = lane >> 5;
    const size_t tok0 = (size_t)b * SEQ;
    LAS unsigned char* kt = wsl; LAS unsigned char* vt = wsl + 8192;
    ATT_ACC(29);
    asm volatile("s_waitcnt vmcnt(0)" ::: "memory");
    sb_dma_k(Kb, tok0 + (size_t)qb * 32, h, kt, lane);
    sb_dma_v(VT, tok0 + (size_t)qb * 32, h, vt, lane);
    bf16x8 qf[8];
    { const bf16_t* qp = Q + (tok0 + (size_t)qb * 32 + r32) * SBW + h * HD + 8 * hi;
#pragma unroll
      for (int st = 0; st < 8; ++st) qf[st] = *(const bf16x8*)(qp + 16 * st); }
    asm volatile("s_waitcnt vmcnt(0)" ::: "memory");
    ATT_ACC(30);
    f32x16 o[4];
#pragma unroll
    for (int d = 0; d < 4; ++d)
#pragma unroll
        for (int r = 0; r < 16; ++r) o[d][r] = 0.f;
    float carry = 0.f;
    const int krow = kperm(r32);
    const LAS unsigned char* kfp = kt + krow * 256;
    const int kx = krow & 15;
    bool first = true;
    for (int kb = qb; kb >= 0; --kb) {
        const int kn = kb > 0 ? kb - 1 : 0;
        int hio = hi; asm volatile("" : "+v"(hio));
        if (!first) asm volatile("s_waitcnt vmcnt(8)" ::: "memory");
        f32x16 sc;
#pragma unroll
        for (int r = 0; r < 16; ++r) sc[r] = 0.f;
        bf16x8 kf[8];
#pragma unroll
        for (int st = 0; st < 8; ++st) kf[st] = *(const LAS bf16x8*)(kfp + (((2 * st + hio) ^ kx) << 4));
        asm volatile("s_waitcnt lgkmcnt(0)" ::: "memory");
        sb_dma_k(Kb, tok0 + (size_t)kn * 32, h, kt, lane);
#pragma unroll
        for (int st = 0; st < 8; ++st) sc = __builtin_amdgcn_mfma_f32_32x32x16_bf16(kf[st], qf[st], sc, 0, 0, 0);
        const bool diag = (kb == qb);
        float L[16];
#pragma unroll
        for (int r = 0; r < 16; ++r) {
            const float z = sc[r];
            const float sp = fmaxf(z, 0.f) + __builtin_amdgcn_logf(1.0f + __builtin_amdgcn_exp2f(-fabsf(z)));
            const bool valid = !diag || (16 * (r >> 3) + 8 * hi + (r & 7) < r32);
            L[r] = valid ? -sp : 0.f;
        }
#pragma unroll
        for (int s2 = 0; s2 < 2; ++s2)
#pragma unroll
            for (int j = 6; j >= 0; --j) L[8 * s2 + j] += L[8 * s2 + j + 1];
        const float g0 = L[0], g1 = L[8];
        const float p0 = xor32_get(g0, hi), p1 = xor32_get(g1, hi);
        const float t1 = g1 + p1, t0 = g0 + p0;
        const float aft1 = (hi == 0 ? p1 : 0.f) + carry, aft0 = t1 + (hi == 0 ? p0 : 0.f) + carry;
        f32x16 p;
#pragma unroll
        for (int r = 0; r < 16; ++r) { const bool valid = !diag || (16 * (r >> 3) + 8 * hi + (r & 7) < r32);
            p[r] = valid ? __builtin_amdgcn_exp2f(sc[r] + L[r] + (r < 8 ? aft0 : aft1)) : 0.f; }
        carry += t0 + t1;
        asm volatile("s_waitcnt vmcnt(8)" ::: "memory");
#pragma unroll
        for (int s2 = 0; s2 < 2; ++s2) {
            u32x4 pp; pp.x = pk2(p[8 * s2], p[8 * s2 + 1]); pp.y = pk2(p[8 * s2 + 2], p[8 * s2 + 3]); pp.z = pk2(p[8 * s2 + 4], p[8 * s2 + 5]); pp.w = pk2(p[8 * s2 + 6], p[8 * s2 + 7]);
            const bf16x8 pf = __builtin_bit_cast(bf16x8, pp);
#pragma unroll
            for (int d = 0; d < 4; ++d) { const int dd = d * 32 + r32;
                const bf16x8 vf = *(const LAS bf16x8*)(vt + dd * 64 + (((2 * s2 + hio) ^ ((dd >> 2) & 3)) << 4));
                o[d] = __builtin_amdgcn_mfma_f32_32x32x16_bf16(pf, vf, o[d], 0, 0, 0); }
        }
        if (DBG_COUNT == 1 && lane == 0) atomicAdd(dbg_cnt, 1u);
        if (__builtin_amdgcn_ballot_w64(carry >= -44.0f) == 0ull) break;
        asm volatile("s_waitcnt lgkmcnt(0)" ::: "memory");
        sb_dma_v(VT, tok0 + (size_t)kn * 32, h, vt, lane);
        first = false;
    }
    ATT_ACC(31);
    asm volatile("s_waitcnt vmcnt(0)" ::: "memory");
    asm volatile("s_waitcnt lgkmcnt(0)" ::: "memory");
#pragma unroll
    for (int d = 0; d < 4; ++d)
#pragma unroll
        for (int r = 0; r < 16; ++r) *(LAS unsigned short*)(wsl + crow(r, hi) * 256 + (d * 32 + r32) * 2) = (unsigned short)f2bf(o[d][r]);
    asm volatile("s_waitcnt lgkmcnt(0)" ::: "memory");
    { char* op = (char*)(Oa + (tok0 + (size_t)qb * 32) * SBW + h * HD);
#pragma unroll
      for (int i = 0; i < 8; ++i) { const int row = 4 * i + (lane >> 4), cc = lane & 15;
          const u32x4 w = *(const LAS u32x4*)(wsl + row * 256 + cc * 16);
          st16u_sc1(op + (size_t)row * (SBW * 2) + cc * 16, w); } }
    asm volatile("s_waitcnt lgkmcnt(0)" ::: "memory");
    ATT_ACC(32);
}

#ifndef SGU_PROBE
#define SGU_PROBE 0
#endif
#define SGU_ACC(slot) do { if (SGU_PROBE && tid == 0) { volatile LAS unsigned long long* t_ = (volatile LAS unsigned long long*)(lds + 131072 + 1024); const unsigned long long n_ = __builtin_amdgcn_s_memrealtime(); t_[slot] += n_ - t_[18]; t_[18] = n_; } } while (0)
template <int NKS>
__device__ __forceinline__ void sgu_mma(int g, int t0, size_t m0, const LAS unsigned char* yt, const bf16_t* SU, const float* sgu_w, const float* sgu_b, const float* lng, const float* lnb, bf16_t* Ob,
                                        const LAS float* mu, const LAS float* rs, LAS float* c1s, LAS float* c2s, const LAS float* sbl  , int r32, int hi) {
    asm volatile("" : "+v"(r32), "+v"(hi));
    f32x16 acc[4];
#pragma unroll
    for (int d = 0; d < 4; ++d)
#pragma unroll
        for (int r = 0; r < 16; ++r) acc[d][r] = 0.f;
    float c1 = 0.f, c2 = 0.f;
    unsigned uu[4][16]; float gn[4], bs[4];
    { const bf16_t* sup = SU + (m0 + t0) * SGW + g * 128 + r32;
#pragma unroll
      for (int r = 0; r < 16; ++r) { const int tl = crow(r, hi);
#pragma unroll
          for (int d = 0; d < 4; ++d) uu[d][r] = sup[(size_t)tl * SGW + d * 32]; }
#pragma unroll
      for (int d = 0; d < 4; ++d) { gn[d] = lng[g * 128 + d * 32 + r32]; bs[d] = lnb[g * 128 + d * 32 + r32]; } }
    const float* wrow = sgu_w + ((size_t)g * 128 + t0 + r32) * 128 + 8 * hi;
#pragma unroll
    for (int kq = 0; kq < NKS / 4; ++kq) {
    f32x4 w0[4], w1[4];
#pragma unroll
    for (int kk = 0; kk < 4; ++kk) { w0[kk] = *(const f32x4*)(wrow + 16 * (4 * kq + kk)); w1[kk] = *(const f32x4*)(wrow + 16 * (4 * kq + kk) + 4); }
#pragma unroll
    for (int kk = 0; kk < 4; ++kk) {
        const int ks = 4 * kq + kk;
        const int k0 = 16 * ks + 8 * hi;
        const f32x4 r0 = *(const LAS f32x4*)(rs + k0), r1 = *(const LAS f32x4*)(rs + k0 + 4), u0 = *(const LAS f32x4*)(mu + k0), u1 = *(const LAS f32x4*)(mu + k0 + 4);
        const f32x4 p0 = w0[kk] * r0, p1 = w1[kk] * r1;
        c1 += (p0[0] * u0[0] + p0[1] * u0[1]) + (p0[2] * u0[2] + p0[3] * u0[3]) + (p1[0] * u1[0] + p1[1] * u1[1]) + (p1[2] * u1[2] + p1[3] * u1[3]);
        c2 += (w0[kk][0] + w0[kk][1]) + (w0[kk][2] + w0[kk][3]) + (w1[kk][0] + w1[kk][1]) + (w1[kk][2] + w1[kk][3]);
        u32x4 ap; ap.x = pk2(p0[0], p0[1]); ap.y = pk2(p0[2], p0[3]); ap.z = pk2(p1[0], p1[1]); ap.w = pk2(p1[2], p1[3]);
        const bf16x8 af = __builtin_bit_cast(bf16x8, ap);
#pragma unroll
        for (int d = 0; d < 4; ++d) { const int dd = d * 32 + r32;
            const bf16x8 bfr = *(const LAS bf16x8*)(yt + dd * 256 + (((2 * ks + hi) ^ (dd & 15)) << 4));
            acc[d] = __builtin_amdgcn_mfma_f32_32x32x16_bf16(af, bfr, acc[d], 0, 0, 0); }
    }
    asm volatile("" ::: "memory"); }
    c1 = xor32_sum(c1); c2 = xor32_sum(c2);
    if (hi == 0) { c1s[r32] = c1; c2s[r32] = c2; }
    LDS_WAIT(); asm volatile("" ::: "memory");
    { const int odd = r32 & 1;
      bf16_t* obp = Ob + (m0 + t0) * SGW + g * 128 + (r32 - odd);
#pragma unroll
      for (int rp = 0; rp < 8; ++rp) { const int r0 = 2 * rp, r1 = r0 + 1; const int tl0 = crow(r0, hi), tl1 = crow(r1, hi);
          const float k10 = c1s[tl0], k20 = c2s[tl0], k30 = sbl[tl0], k11 = c1s[tl1], k21 = c2s[tl1], k31 = sbl[tl1];
#pragma unroll
          for (int d = 0; d < 4; ++d) {
              const unsigned ve = f2bf(__uint_as_float(uu[d][r0] << 16) * (gn[d] * (acc[d][r0] - k10) + bs[d] * k20 + k30));
              const unsigned vo = f2bf(__uint_as_float(uu[d][r1] << 16) * (gn[d] * (acc[d][r1] - k11) + bs[d] * k21 + k31));
              const unsigned snd = odd ? ve : vo;
              const unsigned rcv = (unsigned)__builtin_amdgcn_update_dpp(0, (int)snd, 0xB1, 0xF, 0xF, false);
              const unsigned word = odd ? (rcv | (vo << 16)) : (ve | (rcv << 16));
              *(unsigned*)(obp + (size_t)(odd ? tl1 : tl0) * SGW + d * 32) = word; } } }
    LDS_WAIT(); asm volatile("" ::: "memory");
}
__device__ __forceinline__ void sgu_item(int blk, int half, const bf16_t* SVT  , const bf16_t* SU, const float* sgu_w, const float* sgu_b,
                                         const float* lng, const float* lnb, bf16_t* Ob, LAS unsigned char* lds, int tid) {
    const int lane = tid & 63, wave = __builtin_amdgcn_readfirstlane(tid >> 6), r32 = lane & 31, hi = lane >> 5;
    const size_t m0 = (size_t)blk * 128;
    LAS unsigned char* yt = lds;
    LAS float* part = (LAS float*)(lds + RING_BYTES + 2048);
    LAS float* mu = part + 2048;
    LAS float* rs = mu + 128;
    LAS float* cw = rs + 128;
    LAS float* sbw = cw + 512 + wave * 64;
    __syncthreads();
    const float sbv_ = sgu_b[(half * 4 + (wave >> 1)) * 128 + (wave & 1) * 64 + lane];
    if (SGU_PROBE && tid == 0) ((volatile LAS unsigned long long*)(lds + 131072 + 1024))[18] = __builtin_amdgcn_s_memrealtime();
    { int lane_o = lane; asm volatile("" : "+v"(lane_o));
      const int gi = wave >> 1, rb = 64 * (wave & 1), rsub = lane_o >> 4, p = lane_o & 15;
      const bf16_t* srow = SVT + (size_t)(half * 512 + gi * 128 + rb + rsub) * VTP + m0;
#pragma unroll
      for (int i = 0; i < 16; ++i) { const int c = p ^ ((4 * i + rsub) & 15);
          __builtin_amdgcn_global_load_lds((const unsigned*)(srow + c * 8), (LAS unsigned*)(yt + gi * 32768 + (rb + 4 * i) * 256), 16, 0, 0);
          srow += 4 * VTP; asm volatile("" : "+v"(srow)); } }
    unsigned pf[2];
    { const int l0 = tid, l1 = tid + 512;
      pf[0] = *(const unsigned*)(SU + (m0 + (l0 >> 3)) * SGW + half * 512 + (l0 & 7) * 64); pf[1] = *(const unsigned*)(SU + (m0 + (l1 >> 3)) * SGW + half * 512 + (l1 & 7) * 64); }
    { float sm[8], sq[8];
#pragma unroll
      for (int t = 0; t < 8; ++t) { sm[t] = 0.f; sq[t] = 0.f; }
      const int rsub = lane >> 4, ch16 = lane & 15;
      const bf16_t* src = SVT + (size_t)(wave * 128 + rsub) * VTP + m0 + 8 * ch16;
#pragma unroll
      for (int hb = 0; hb < 2; ++hb) {
      u32x4 u[16];
#pragma unroll
      for (int i = 0; i < 16; ++i) u[i] = *(const u32x4*)(src + (size_t)(4 * (16 * hb + i)) * VTP);
#pragma unroll
      for (int i = 0; i < 16; ++i) {
          const float x[8] = {bflo(u[i].x), bfhi(u[i].x), bflo(u[i].y), bfhi(u[i].y), bflo(u[i].z), bfhi(u[i].z), bflo(u[i].w), bfhi(u[i].w)};
#pragma unroll
          for (int t = 0; t < 8; ++t) { sm[t] += x[t]; sq[t] += x[t] * x[t]; } }
      asm volatile("" ::: "memory"); }
#pragma unroll
      for (int t = 0; t < 8; ++t) { sm[t] = xor32_sum(xor16_sum(sm[t])); sq[t] = xor32_sum(xor16_sum(sq[t])); }
      if (lane < 16) {
#pragma unroll
          for (int t = 0; t < 8; ++t) { part[(wave * 128 + 8 * ch16 + t) * 2] = sm[t]; part[(wave * 128 + 8 * ch16 + t) * 2 + 1] = sq[t]; } } }
    sbw[lane] = sbv_;
    SGU_ACC(30);
    __syncthreads();
    SGU_ACC(31);
    if (tid < 128) { float s = 0.f, q = 0.f;
#pragma unroll
        for (int w = 0; w < 8; ++w) { s += part[(w * 128 + tid) * 2]; q += part[(w * 128 + tid) * 2 + 1]; }
        const float mean = s * (1.0f / 1024.0f); const float var = fmaxf(q * (1.0f / 1024.0f) - mean * mean, 0.f);
        mu[tid] = mean; rs[tid] = 1.0f / sqrtf(var + LN_EPS); }
    __syncthreads();
    const int g = half * 4 + (wave >> 1), th = wave & 1;
    LAS float* c1s = cw + wave * 64; LAS float* c2s = c1s + 32;
    const LAS unsigned char* ytg = yt + (wave >> 1) * 32768;
    SGU_ACC(32);
    for (int tb = 0; tb < 2; ++tb) {
        const int t0 = th * 64 + tb * 32;
        if (th) sgu_mma<8>(g, t0, m0, ytg, SU, sgu_w, sgu_b, lng, lnb, Ob, mu, rs, c1s, c2s, sbw + tb * 32, r32, hi);
        else    sgu_mma<4>(g, t0, m0, ytg, SU, sgu_w, sgu_b, lng, lnb, Ob, mu, rs, c1s, c2s, sbw + tb * 32, r32, hi);
    }
    asm volatile("" :: "v"(pf[0]), "v"(pf[1]));
    SGU_ACC(33);
    __syncthreads();
}

struct Args { const float* in[23]; float* out; unsigned char* ws; int ph_lo, ph_hi; };
constexpr int NPHASE = 10;

__global__ void __launch_bounds__(NWAVES * 64, 2) mk_fwd(Args args) {
    extern __shared__ __attribute__((aligned(16))) unsigned char lds_raw[];
    LAS unsigned char* lds = (LAS unsigned char*)lds_raw;
    volatile LAS unsigned* MISC = (volatile LAS unsigned*)(lds + MISC_OFF);
    const int tid = threadIdx.x, lane = tid & 63, wave = __builtin_amdgcn_readfirstlane(tid >> 6);
    const int G = gridDim.x, bx = blockIdx.x;
    const int vcu = (G % 8 == 0) ? (bx % 8) * (G / 8) + bx / 8 : bx;
    const int gw = vcu * NWAVES + wave, NGW = G * NWAVES;
#define XL_MODE  (__builtin_amdgcn_readfirstlane((int)MISC[11]) != 0)
#define XL_VBX   __builtin_amdgcn_readfirstlane((int)MISC[12])
#define XL_VCU   __builtin_amdgcn_readfirstlane((int)MISC[13])
#define XL_XCC   __builtin_amdgcn_readfirstlane((int)MISC[14])
#define XL_RANK  __builtin_amdgcn_readfirstlane((int)MISC[15])
    unsigned char* ws = args.ws;
    unsigned* ctl = (unsigned*)(ws + WS_CTL);
    const float* x = args.in[0]; const float* cvec = args.in[1]; const float* w_ada = args.in[2]; const float* b_ada = args.in[3]; const float* w_in = args.in[4];
    const float* sgu_w = args.in[5]; const float* sgu_b = args.in[6]; const float* sgu_lng = args.in[7]; const float* sgu_lnb = args.in[8];
    const float* w_pa = args.in[9]; const float* w_pb = args.in[10]; const float* w_out = args.in[11]; const float* ln1g = args.in[12]; const float* ln1b = args.in[13];
    const float* w_group = args.in[14]; const float* b_group = args.in[15]; const float* w_router = args.in[16]; const float* b_router = args.in[17];
    const float* w_gate = args.in[18]; const float* w_up = args.in[19]; const float* w_down = args.in[20]; const float* ln2g = args.in[21]; const float* ln2b = args.in[22];
    float* modp = (float*)(ws + WS_MODP); float* mod = (float*)(ws + WS_MOD);
    int* toklist = (int*)(ws + WS_TOK); int* asg = (int*)(ws + WS_ASG);
    bf16_t* Wab = (bf16_t*)(ws + WS_WAB); bf16_t* Wout = (bf16_t*)(ws + WS_WOUT); bf16_t* Wgu = (bf16_t*)(ws + WS_WGU); bf16_t* Wd = (bf16_t*)(ws + WS_WD); bf16_t* Win = (bf16_t*)(ws + WS_WIN);
    bf16_t* Hb = (bf16_t*)(ws + WS_H); bf16_t* Qb = (bf16_t*)(ws + WS_Q); bf16_t* Kb = (bf16_t*)(ws + WS_K); bf16_t* SUb = (bf16_t*)(ws + WS_SU); bf16_t* VTb = (bf16_t*)(ws + WS_VT);
    bf16_t* MRG = (bf16_t*)(ws + WS_MRG); bf16_t* YS = (bf16_t*)(ws + WS_YS); bf16_t* SAb = (bf16_t*)(ws + WS_SA); bf16_t* SBb = (bf16_t*)(ws + WS_SB);
    float* V1 = (float*)(ws + WS_V1); bf16_t* OAB = (bf16_t*)(ws + WS_OAB); bf16_t* HBb = (bf16_t*)(ws + WS_HB);
    bf16_t* Yb = (bf16_t*)(ws + WS_SB);
    unsigned char* Win8 = (unsigned char*)Win + (size_t)2048 * HP * 2;
    unsigned char* H8 = ws + WS_OAB;

    for (int u = tid; u < (LDS_BYTES - LDSCTL_OFF) / 4; u += NWAVES * 64) ((LAS unsigned*)(lds + LDSCTL_OFF))[u] = 0u;
    __syncthreads();
    if (tid == 0) { MISC[11] = 0u; MISC[12] = (unsigned)bx; MISC[13] = (unsigned)vcu; MISC[14] = 0u; MISC[15] = 0u; }
    __syncthreads();
    XcdBarrier bar; bar.bar = ctl + CW_BAR; bar.x = 0; bar.st = nullptr;
#if !MK_PER_PHASE
    bar = xcd_barrier_post(ctl + CW_BAR, MISC + 8);
#ifndef SPREAD_PH
#define SPREAD_PH -1
#endif
#ifndef SPREAD_SEL
#define SPREAD_SEL 0
#endif
    int bar_idx = 0;
#define GRID_BAR() do { if (SPREAD_PH >= 0 && tid == 0 && bar_idx == SPREAD_PH - 1) { const unsigned d_ = (unsigned)(__builtin_amdgcn_s_memrealtime() - ((volatile LAS unsigned long long*)(lds + LDSCTL_OFF + 1024))[SPREAD_PH]); atomicMax(ctl + 3010, d_); atomicMax(ctl + 3011, 1000000u - d_); } ++bar_idx; xcd_barrier(bar); } while (0)
#define LOCAL_BAR() do { if (XL_MODE) { ++bar_idx; xcd_local_barrier(bar); } else GRID_BAR(); } while (0)
#else
#define GRID_BAR() do { } while (0)
#define LOCAL_BAR() do { } while (0)
#endif
    const int lo = args.ph_lo, hi_ph = args.ph_hi;
#ifndef TS_A
#define TS_A -1
#endif
#ifndef TS_B
#define TS_B 5
#endif
#ifndef TS_DIV
#define TS_DIV 2.0f
#endif
#define STAMP(k) do { if (TS_A >= 0 && tid == 0) ((volatile LAS unsigned long long*)(lds + LDSCTL_OFF + 1024))[k] = __builtin_amdgcn_s_memrealtime(); } while (0)
    STAMP(0);
#define ACC_BEGIN() do { if (TS_A >= 0 && tid == 0) { volatile LAS unsigned long long* t_ = (volatile LAS unsigned long long*)(lds + LDSCTL_OFF + 1024); t_[18] = __builtin_amdgcn_s_memrealtime(); } } while (0)
#define ACC_TO(slot) do { if (TS_A >= 0 && tid == 0) { volatile LAS unsigned long long* t_ = (volatile LAS unsigned long long*)(lds + LDSCTL_OFF + 1024); const unsigned long long n_ = __builtin_amdgcn_s_memrealtime(); t_[slot] += n_ - t_[18]; t_[18] = n_; } } while (0)
#ifndef PH_MASK
#define PH_MASK 0x3ff
#endif
#define IN(k) (((PH_MASK >> (k)) & 1) && lo <= (k) && (k) < hi_ph)
#define BOTH(k) (IN(k) && IN((k) + 1))
#ifndef REP_MASK
#define REP_MASK 0
#endif
#ifndef ATT_REP
#define ATT_REP 1
#endif
#ifndef SGU_REP
#define SGU_REP 1
#endif
#define NREP(k) ((((REP_MASK) >> (k)) & 1) ? 2 : 1)

    if (IN(0)) for (int rep_ = 0; rep_ < NREP(0); ++rep_) {
        LAS float* sl = (LAS float*)lds;
        for (int item = vcu; item < 256; item += G) {
            const int cc = item & 31, ks = item >> 5;
            { const int b = tid >> 8, kk = tid & 255; const float v = cvec[b * DM + ks * 256 + kk]; sl[tid] = v / (1.0f + __expf(-v)); }
            __syncthreads();
            const int cg = tid % 96, sub = tid / 96;
            f32x4 a0 = {0.f, 0.f, 0.f, 0.f}, a1 = {0.f, 0.f, 0.f, 0.f};
            if (sub < 4) {
                const float* wp = w_ada + (size_t)(ks * 256 + sub * 64) * MODW + cc * 384 + cg * 4;
#pragma unroll 8
                for (int i = 0; i < 64; ++i) { const f32x4 w = __builtin_nontemporal_load((const f32x4*)(wp + (size_t)i * MODW)); a0 += w * sl[sub * 64 + i]; a1 += w * sl[256 + sub * 64 + i]; }
            }
            LAS float* red = sl + 512;
            if (sub < 4) { *(LAS f32x4*)(red + (sub * 2 + 0) * 384 + cg * 4) = a0; *(LAS f32x4*)(red + (sub * 2 + 1) * 384 + cg * 4) = a1; }
            __syncthreads();
            if (tid < 192) { const int b = tid / 96, gq = tid % 96; f32x4 s = {0.f, 0.f, 0.f, 0.f};
#pragma unroll
                for (int sb = 0; sb < 4; ++sb) s += *(LAS f32x4*)(red + (sb * 2 + b) * 384 + gq * 4);
                *(f32x4*)(modp + ((size_t)ks * 2 + b) * MODW + cc * 384 + gq * 4) = s; }
            __syncthreads();
        }
        { int nd = 0; for (int item = vcu; item < 256; item += G) ++nd;
          asm volatile("s_waitcnt vmcnt(0)" ::: "memory");
          __syncthreads();
          if (tid == 0 && nd > 0) { __builtin_amdgcn_fence(__ATOMIC_RELEASE, "agent"); asm volatile("s_waitcnt vmcnt(0)" ::: "memory");
              __hip_atomic_fetch_add(ctl + CW_MODC, (unsigned)nd, __ATOMIC_RELAXED, __HIP_MEMORY_SCOPE_AGENT); } }
        { bf16_t* wrh = (bf16_t*)(ws + WS_WRT); bf16_t* wrl = wrh + 48 * HP;
          for (int t8 = vcu * (NWAVES * 64) + tid; t8 < 48 * DM / 8; t8 += G * NWAVES * 64) { const int c = t8 >> 8, k0 = (t8 & 255) * 8;
              unsigned hi[8], lo[8];
#pragma unroll
              for (int j = 0; j < 8; ++j) { const int k = k0 + j; const float v = c < 32 ? w_router[(size_t)k * 32 + c] : (c < 36 ? w_group[(size_t)k * 4 + (c - 32)] : 0.f);
                  hi[j] = f2bf(v); lo[j] = f2bf(v - __uint_as_float(hi[j] << 16)); }
              u32x4 oh, ol; oh.x = hi[0] | (hi[1] << 16); oh.y = hi[2] | (hi[3] << 16); oh.z = hi[4] | (hi[5] << 16); oh.w = hi[6] | (hi[7] << 16);
              ol.x = lo[0] | (lo[1] << 16); ol.y = lo[2] | (lo[3] << 16); ol.z = lo[4] | (lo[5] << 16); ol.w = lo[6] | (lo[7] << 16);
              st16u_sc1(wrh + (size_t)c * HP + k0, oh); st16u_sc1(wrl + (size_t)c * HP + k0, ol); } }
        LAS float* scr = (LAS float*)(lds + wave * 16384);
        constexpr int I_IN = 32 * 288, I_P = 16 * 64, I_O = 32 * 64, I_G = 32 * 16  , I_D = 8 * 64  ;
        constexpr int NITEMS = I_IN + 2 * I_P + I_O + NE * (2 * I_G + I_D);
        for (int it = gw; it < NITEMS; it += NGW) {
            int r = it;
            if (r < I_IN) { const int kb = r / 288, nb = r % 288, n0 = 32 * nb;
                if (win_is_bf16(n0)) transpose_item(w_in, DM, INC, Win, 64 * kb, n0, win_dst(n0) - n0, scr, lane, HP);
                else transpose_item_fp8_wt(w_in, DM, INC, Win8, 64 * kb, n0, win8_dst(n0) - n0, scr, lane);
                continue; } r -= I_IN;
            if (r < I_P) { const int kb = r / 64, nb = r % 64; transpose_item(w_pa, 1024, DM, Wab, 64 * kb, 32 * nb, 0, scr, lane); continue; } r -= I_P;
            if (r < I_P) { const int kb = r / 64, nb = r % 64; transpose_item(w_pb, 1024, DM, Wab, 64 * kb, 32 * nb, 2048, scr, lane); continue; } r -= I_P;
            if (r < I_O) { const int kb = r / 64, nb = r % 64; transpose_item(w_out, DM, DM, Wout, 64 * kb, 32 * nb, 0, scr, lane); continue; } r -= I_O;
            if (r < NE * I_G) { const int e = r / I_G, q = r % I_G, kb = q / 16, nb = q % 16, n0 = 32 * nb;
                transpose_item_fp8(w_gate + (size_t)e * DM * DE, DM, DE, (unsigned char*)Wgu + (size_t)e * 1024 * DM, 64 * kb, n0, 128 * (n0 / 128), scr, lane); continue; } r -= NE * I_G;
            if (r < NE * I_G) { const int e = r / I_G, q = r % I_G, kb = q / 16, nb = q % 16, n0 = 32 * nb;
                transpose_item_fp8(w_up + (size_t)e * DM * DE, DM, DE, (unsigned char*)Wgu + (size_t)e * 1024 * DM, 64 * kb, n0, 128 * (n0 / 128) + 128, scr, lane); continue; } r -= NE * I_G;
            { const int e = r / I_D, q = r % I_D, kb = q / 64, nb = q % 64;
                transpose_item_fp8(w_down + (size_t)e * DE * DM, DE, DM, (unsigned char*)Wd + (size_t)e * DM * DE, 64 * kb, 32 * nb, 0, scr, lane); }
        }
        asm volatile("s_waitcnt vmcnt(0)" ::: "memory");
        __syncthreads();
        if (tid == 0 && rep_ == 0) __hip_atomic_fetch_add(ctl + CW_P0D, 1u, __ATOMIC_RELAXED, __HIP_MEMORY_SCOPE_AGENT);
        if (rep_ + 1 < NREP(0)) GRID_BAR();
        STAMP(1);
    }

    if (IN(1)) for (int rep_ = 0; rep_ < NREP(1); ++rep_) {
        if (IN(0)) {
            if (tid == 0) { unsigned sp = 0; while (__hip_atomic_load(ctl + CW_MODC, RLX_AGENT) < 256u) { __builtin_amdgcn_s_sleep(2); if (++sp > (1u << 22)) break; }
                __builtin_amdgcn_fence(__ATOMIC_ACQUIRE, "agent"); asm volatile("s_waitcnt vmcnt(0)" ::: "memory");
#if !MK_PER_PHASE
                if (MISC[8] == 0u) { unsigned nl_, nx_, a32_; xcd_barrier_complete(bar.bar, bar.x, nl_, nx_, a32_); MISC[8] = nl_; MISC[9] = nx_; MISC[11] = a32_;
                    if (a32_) { const unsigned rk = MISC[10], xc = bar.x; MISC[12] = rk * 8u + xc; MISC[13] = xc * 32u + rk; MISC[14] = xc; MISC[15] = rk; } }
#endif
            }
            __syncthreads();
        }
        LAS float* ms = (LAS float*)lds;
        for (int idx = tid; idx < 8192; idx += NWAVES * 64) { const int b = idx >> 12, j = idx & 4095; float v = b_ada[j];
#pragma unroll
            for (int p = 0; p < 8; ++p) v += modp[((size_t)p * 2 + b) * MODW + j];
            ms[idx] = (j >= DM) ? 1.0f + v : v; }
        for (int idx = vcu * (NWAVES * 64) + tid; idx < 2 * MODW; idx += G * NWAVES * 64) { const int b = idx / MODW, j = idx % MODW; float v = b_ada[j];
#pragma unroll
            for (int p = 0; p < 8; ++p) v += modp[((size_t)p * 2 + b) * MODW + j];
            __hip_atomic_store(mod + idx, v, __ATOMIC_RELAXED, __HIP_MEMORY_SCOPE_AGENT); }
        __syncthreads();
        const bool xl1 = XL_MODE;
        const int m_first = xl1 ? 2048 * XL_XCC + XL_RANK * NWAVES + wave : gw, m_stride = xl1 ? 256 : NGW, m_end = xl1 ? 2048 * (XL_XCC + 1) : M;
        for (int m = m_first; m < m_end; m += m_stride) {
            const int b = m >> 13;
            const f32x4* xr = (const f32x4*)(x + (size_t)m * DM) + lane;
            f32x4 v[8]; float s = 0.f;
#pragma unroll
            for (int j = 0; j < 8; ++j) { v[j] = xr[64 * j]; s += (v[j].x + v[j].y) + (v[j].z + v[j].w); }
            const float mean = wave_sum(s) * (1.0f / DM); float s2 = 0.f;
#pragma unroll
            for (int j = 0; j < 8; ++j) { v[j] = v[j] - mean; s2 += (v[j].x * v[j].x + v[j].y * v[j].y) + (v[j].z * v[j].z + v[j].w * v[j].w); }
            const float rstd = 1.0f / sqrtf(wave_sum(s2) * (1.0f / DM) + LN_EPS);
            u32x2* o8 = (u32x2*)(Hb + (size_t)m * HP) + lane; unsigned* o4 = (unsigned*)(H8 + (size_t)m * DM) + lane;
#pragma unroll
            for (int j = 0; j < 8; ++j) { const f32x4 sh = *(const LAS f32x4*)(ms + (b * 2) * DM + 256 * j + 4 * lane), sc = *(const LAS f32x4*)(ms + (b * 2 + 1) * DM + 256 * j + 4 * lane);
                const f32x4 hv = v[j] * rstd * sc + sh; u32x2 w; w.x = pk2(hv.x, hv.y); w.y = pk2(hv.z, hv.w); o8[64 * j] = w; o4[64 * j] = pk4_fp8(hv.x, hv.y, hv.z, hv.w); }
        }
        __syncthreads();
        if (BOTH(1) || rep_ + 1 < NREP(1)) {
            if (XL_MODE && IN(0)) { ++bar_idx; xcd_local_barrier(bar, ctl + CW_P0D, (unsigned)G); }
            else GRID_BAR();
        }
        STAMP(2);
    }

#if !MK_PER_PHASE
    if (IN(1) && IN(2)) {
        if (tid == 0 && MISC[8 + 3] != 0u) { const unsigned rk = MISC[8 + 2], xc = bar.x; MISC[11] = 1u; MISC[12] = rk * 8u + xc; MISC[13] = xc * 32u + rk; MISC[14] = xc; MISC[15] = rk; }
        __syncthreads();
    }
#endif
    if (TS_A >= 0 && tid == 0) { volatile LAS unsigned long long* t_ = (volatile LAS unsigned long long*)(lds + LDSCTL_OFF + 1024); t_[16] = 100ull * (XL_MODE ? 7u : 3u); }
    if (IN(2)) for (int rep_ = 0; rep_ < NREP(2); ++rep_) {
        { pg8::Gemm g{Hb, Win, DM, HP, HP}; pg8::StaticOrder S; S.init(M, 2048, G, XL_VBX);
          pg8::EpiG1 E{Qb, Kb, SUb, SAb, SBb};
          pg8::gemm_phase<pg8::EpiG1, pg8::StaticOrder, true>(lds, g, S, E); }
        STAMP(11);
        { pg8::Gemm g{(const bf16_t*)H8, (const bf16_t*)Win8, DM / 2}; pg8::StaticOrder S; S.init(M, 5120, G, XL_VBX);
          pg8::EpiGates E{SAb, SBb, SUb};
          pg8::gemm_phase<pg8::EpiGates, pg8::StaticOrder, true, true>(lds, g, S, E); }
        STAMP(12);
        { pg8::Gemm g{(const bf16_t*)(Win8 + (size_t)5120 * DM), (const bf16_t*)H8, DM / 2}; pg8::StaticOrder S; S.init(2048, M, G, XL_VBX);
          pg8::EpiG2 E{VTb};
          pg8::gemm_phase<pg8::EpiG2, pg8::StaticOrder, true, true>(lds, g, S, E); }
        if (BOTH(2) || rep_ + 1 < NREP(2)) {
            if (XL_MODE && IN(0) && IN(1)) { ++bar_idx; xcd_local_barrier(bar, nullptr, 0u, ctl + CW_XD + 64 * XL_XCC); }
            else GRID_BAR();
        }
        STAMP(3);
    }

    if (IN(3)) for (int rep_ = 0; rep_ < NREP(3); ++rep_) {
        ACC_BEGIN();
        const unsigned long long dbt0 = DBG_COUNT ? __builtin_amdgcn_s_memrealtime() : 0ull;
        for (int item2 = XL_VCU; item2 < SGU_REP * 256; item2 += G) { const int item = item2 & 255;
            sgu_item(item >> 1, item & 1, VTb + (size_t)1024 * VTP, SUb, sgu_w, sgu_b, sgu_lng, sgu_lnb, OAB + (size_t)M * SBW, lds, tid); }
        ACC_TO(24);
        const unsigned long long dbt1 = DBG_COUNT ? __builtin_amdgcn_s_memrealtime() : 0ull;
        if (XL_MODE && IN(0) && IN(1) && IN(2)) {
            if (tid == 0) { const int xc = XL_XCC;
                for (int xo = xc & ~3; xo < xc; ++xo) XB_SPIN(xb_ld(ctl + CW_XD + 64 * xo) < 1u, bar.bar);
                __builtin_amdgcn_fence(__ATOMIC_ACQUIRE, "agent"); asm volatile("s_waitcnt vmcnt(0)" ::: "memory"); }
            __syncthreads();
        }
        { const bool xl = XL_MODE; const int xcc_v = XL_XCC, rank_v = XL_RANK;
          for (int U2 = gw; U2 < ATT_REP * BATCH * NHEAD * (SEQ / 32); U2 += NGW) {
            const int U = U2 % (BATCH * NHEAD * (SEQ / 32));
            const int j = rank_v * NWAVES + wave + 256 * (U2 / NGW);
            const int bh = xl ? (xcc_v >> 2) * 8 + (j >> 6) : U >> 8, qb = xl ? (xcc_v & 3) * 64 + (j & 63) : U & 255;
            sb_attn_unit(bh >> 3, bh & 7, qb, Qb, Kb, VTb, OAB, lds + wave * 16384, lane, ctl + 3000);
          } }
        ACC_TO(25);
        if (DBG_COUNT && lane == 0) { const unsigned long long dbt2 = __builtin_amdgcn_s_memrealtime();
            atomicMax(ctl + 3001, (unsigned)(dbt1 - dbt0)); atomicMax(ctl + 3002, (unsigned)(dbt2 - dbt1)); atomicAdd(ctl + 3003, (unsigned)(dbt2 - dbt1)); atomicMin(ctl + 3004, 0xffffffffu - (unsigned)(dbt2 - dbt1)); }
        if (BOTH(3) || rep_ + 1 < NREP(3)) LOCAL_BAR();
        STAMP(4);
    }

    if (IN(4)) for (int rep_ = 0; rep_ < NREP(4); ++rep_) {
        pg8::Gemm g{OAB, Wab, 1024}; pg8::PairOrder S; S.so.init(M, DM, G, XL_VBX);
        pg8::EpiGate E{SAb, SBb, MRG};
        pg8::gemm_phase<pg8::EpiGate, pg8::PairOrder, true>(lds, g, S, E);
        if (BOTH(4) || rep_ + 1 < NREP(4)) LOCAL_BAR();
        STAMP(5);
    }

    if (IN(5)) for (int rep_ = 0; rep_ < NREP(5); ++rep_) {
        pg8::Gemm g{MRG, Wout, DM, GP}; pg8::StaticOrder S; S.init(M, DM, G, XL_VBX);
        pg8::EpiY E{Yb};
        pg8::gemm_phase<pg8::EpiY, pg8::StaticOrder, true>(lds, g, S, E);
        if (BOTH(5) || rep_ + 1 < NREP(5)) LOCAL_BAR();
        STAMP(6);
    }

    if (IN(6)) for (int rep_ = 0; rep_ < NREP(6); ++rep_) {
        constexpr int ROWB = 2064, PLANE = 16 * ROWB;
        LAS unsigned char* thi = lds; LAS unsigned char* tlo = lds + PLANE;
        LAS float* red = (LAS float*)lds;
        LAS float* pv = (LAS float*)(lds + 2 * PLANE);
        LAS int* rl = (LAS int*)(lds + 2 * PLANE + 5 * 8192);
        const bf16_t* wrh = (const bf16_t*)(ws + WS_WRT); const bf16_t* wrl = wrh + 48 * HP;
        int pvb = -1;
        __syncthreads();
        for (int idx = tid; idx < 2048; idx += NWAVES * 64) { pv[idx] = ln1g[idx]; pv[2048 + idx] = ln1b[idx]; }
        const bool xl = XL_MODE; const int it_first = xl ? XL_XCC * 128 + XL_RANK : vcu, it_stride = xl ? 32 : G;
        for (int it0 = it_first; it0 < (xl ? it_first + 1 : M / 16); it0 += 4 * G) {
        if (tid < 32) rl[tid] = 0;
        __syncthreads();
        for (int ii = 0; ii < 4; ++ii) {
            const int it = it0 + ii * it_stride; if (it >= M / 16) break;
            const int mbase = it * 16 + wave * 2, bq = it >> 9;
            if (bq != pvb) {
                __syncthreads();
                for (int idx = tid; idx < 2048; idx += NWAVES * 64) { float m2 = b_ada[2 * DM + idx], m3 = b_ada[3 * DM + idx], m4 = b_ada[4 * DM + idx];
#pragma unroll
                    for (int p = 0; p < 8; ++p) { const float* mp = modp + ((size_t)p * 2 + bq) * MODW + idx; m2 += mp[2 * DM]; m3 += mp[3 * DM]; m4 += mp[4 * DM]; }
                    pv[4096 + idx] = m3; pv[6144 + idx] = 1.0f + m4; pv[8192 + idx] = m2; }
                pvb = bq;
                __syncthreads();
            }
            ACC_BEGIN();
            const int arow = lane & 15, kg = lane >> 4;
            bf16x8 wfh[4][3], wfl[4][3];
#define P6_LOADWF(dst, src, hh_) do { int ar_ = arow; asm volatile("" : "+v"(ar_));   \
                _Pragma("unroll") for (int cb = 0; cb < 3; ++cb) { const bf16_t* wp_ = src + (size_t)(cb * 16 + ar_) * HP + 1024 * (hh_) + 128 * wave + 8 * kg; \
                    _Pragma("unroll") for (int ks = 0; ks < 4; ++ks) dst[ks][cb] = *(const bf16x8*)(wp_ + 32 * ks); } } while (0)
            P6_LOADWF(wfh, wrh, 0); P6_LOADWF(wfl, wrl, 0);
            f32x4 h2v[2][4];
#pragma unroll
            for (int rr = 0; rr < 2; ++rr) {
                int lane_o = lane; asm volatile("" : "+v"(lane_o));
                u32x2* vr = (u32x2*)((bf16_t*)V1 + (size_t)(mbase + rr) * GP) + lane_o;
                const f32x4* xr = (const f32x4*)(x + (size_t)(mbase + rr) * DM) + lane_o; const u32x2* yr = (const u32x2*)(Yb + (size_t)(mbase + rr) * GP) + lane_o;
                f32x4 v[8]; u32x2 yv[8]; float s = 0.f;
#pragma unroll
                for (int j = 0; j < 8; ++j) { v[j] = xr[64 * j]; yv[j] = yr[64 * j]; }
                f32x4 g1n = *(const LAS f32x4*)(pv + 4 * 2048 + 4 * lane_o);
#pragma unroll
                for (int j = 0; j < 8; ++j) { const f32x4 g1 = g1n; if (j < 7) g1n = *(const LAS f32x4*)(pv + 4 * 2048 + 256 * (j + 1) + 4 * lane_o);
                    const f32x4 yf = {bflo(yv[j].x), bfhi(yv[j].x), bflo(yv[j].y), bfhi(yv[j].y)};
                    v[j] = v[j] * ALPHA + g1 * yf; s += (v[j].x + v[j].y) + (v[j].z + v[j].w); __builtin_amdgcn_sched_barrier(0); }
                float mean = wave_sum(s) * (1.0f / DM); float s2 = 0.f;
#pragma unroll
                for (int j = 0; j < 8; ++j) { v[j] = v[j] - mean; s2 += (v[j].x * v[j].x + v[j].y * v[j].y) + (v[j].z * v[j].z + v[j].w * v[j].w); }
                float rstd = 1.0f / sqrtf(wave_sum(s2) * (1.0f / DM) + LN_EPS);
                s = 0.f;
                f32x4 gqn = *(const LAS f32x4*)(pv + 4 * lane_o), bbn = *(const LAS f32x4*)(pv + 2048 + 4 * lane_o);
                unsigned x1keep[2];
#pragma unroll
                for (int j = 0; j < 8; ++j) { const f32x4 gq = gqn, bb = bbn; if (j < 7) { gqn = *(const LAS f32x4*)(pv + 256 * (j + 1) + 4 * lane_o); bbn = *(const LAS f32x4*)(pv + 2048 + 256 * (j + 1) + 4 * lane_o); }
                    v[j] = v[j] * rstd * gq + bb;
                    { const unsigned wx = pk2(v[j].x, v[j].y), wy = pk2(v[j].z, v[j].w);
                      if ((j & 1) == 0) { x1keep[0] = wx; x1keep[1] = wy; }
                      else { const bool odd_ = (lane_o & 1) != 0;
                          const unsigned sx = odd_ ? x1keep[0] : wx, sy = odd_ ? x1keep[1] : wy;
                          const unsigned rx = (unsigned)__builtin_amdgcn_update_dpp(0, (int)sx, 0xB1, 0xF, 0xF, false), ry = (unsigned)__builtin_amdgcn_update_dpp(0, (int)sy, 0xB1, 0xF, 0xF, false);
                          u32x4 w4; if (odd_) { w4.x = rx; w4.y = ry; w4.z = wx; w4.w = wy; } else { w4.x = x1keep[0]; w4.y = x1keep[1]; w4.z = rx; w4.w = ry; }
                          st16u_sc1((char*)vr + (size_t)(odd_ ? 512 * j - 8 : 512 * (j - 1)), w4); } }
                    s += (v[j].x + v[j].y) + (v[j].z + v[j].w); __builtin_amdgcn_sched_barrier(0); }
                mean = wave_sum(s) * (1.0f / DM); s2 = 0.f;
#pragma unroll
                for (int j = 0; j < 8; ++j) { const f32x4 d = v[j] - mean; s2 += (d.x * d.x + d.y * d.y) + (d.z * d.z + d.w * d.w); }
                rstd = 1.0f / sqrtf(wave_sum(s2) * (1.0f / DM) + LN_EPS);
                unsigned* ho = (unsigned*)((unsigned char*)Hb + (size_t)(mbase + rr) * (2 * HP)) + lane_o;
                f32x4 shn = *(const LAS f32x4*)(pv + 2 * 2048 + 4 * lane_o), scn = *(const LAS f32x4*)(pv + 3 * 2048 + 4 * lane_o);
#pragma unroll
                for (int j = 0; j < 8; ++j) { const f32x4 sh = shn, sc = scn; if (j < 7) { shn = *(const LAS f32x4*)(pv + 2 * 2048 + 256 * (j + 1) + 4 * lane_o); scn = *(const LAS f32x4*)(pv + 3 * 2048 + 256 * (j + 1) + 4 * lane_o); }
                    const f32x4 hv = (v[j] - mean) * rstd * sc + sh; ho[64 * j] = pk4_fp8(hv.x, hv.y, hv.z, hv.w);
                    if (j >= 4) h2v[rr][j - 4] = hv;
                    else { u32x2 hb; hb.x = pk2(hv.x, hv.y); hb.y = pk2(hv.z, hv.w);
                        u32x2 lb; lb.x = pk2(hv.x - bflo(hb.x), hv.y - bfhi(hb.x)); lb.y = pk2(hv.z - bflo(hb.y), hv.w - bfhi(hb.y));
                        *(LAS u32x2*)(thi + (wave * 2 + rr) * ROWB + 8 * lane_o + 512 * j) = hb; *(LAS u32x2*)(tlo + (wave * 2 + rr) * ROWB + 8 * lane_o + 512 * j) = lb; }
                    __builtin_amdgcn_sched_barrier(0); }
            }
            ACC_TO(20);
            f32x4 lacc[3];
#pragma unroll
            for (int cb = 0; cb < 3; ++cb) lacc[cb] = (f32x4){0.f, 0.f, 0.f, 0.f};
#pragma unroll 1
            for (int hh = 0; hh < 2; ++hh) {
                if (hh == 1) {
#pragma unroll
                for (int rr = 0; rr < 2; ++rr) {
                    LAS unsigned char* dh = thi + (wave * 2 + rr) * ROWB + 8 * lane; LAS unsigned char* dl = tlo + (wave * 2 + rr) * ROWB + 8 * lane;
#pragma unroll
                    for (int j = 0; j < 4; ++j) { const f32x4 hv = h2v[rr][j];
                        u32x2 hb; hb.x = pk2(hv.x, hv.y); hb.y = pk2(hv.z, hv.w);
                        u32x2 lb; lb.x = pk2(hv.x - bflo(hb.x), hv.y - bfhi(hb.x)); lb.y = pk2(hv.z - bflo(hb.y), hv.w - bfhi(hb.y));
                        *(LAS u32x2*)(dh + 512 * j) = hb; *(LAS u32x2*)(dl + 512 * j) = lb; }
                } }
                asm volatile("s_waitcnt lgkmcnt(0)" ::: "memory"); __builtin_amdgcn_s_barrier(); asm volatile("" ::: "memory");
                bf16x8 ah[4], al[4];
#pragma unroll
                for (int ks = 0; ks < 4; ++ks) { const int ko = (128 * wave + 32 * ks + 8 * kg) * 2; ah[ks] = *(const LAS bf16x8*)(thi + arow * ROWB + ko); al[ks] = *(const LAS bf16x8*)(tlo + arow * ROWB + ko); }
#pragma unroll
                for (int ks = 0; ks < 4; ++ks)
#pragma unroll
                    for (int cb = 0; cb < 3; ++cb) { lacc[cb] = __builtin_amdgcn_mfma_f32_16x16x32_bf16(ah[ks], wfh[ks][cb], lacc[cb], 0, 0, 0); lacc[cb] = __builtin_amdgcn_mfma_f32_16x16x32_bf16(al[ks], wfh[ks][cb], lacc[cb], 0, 0, 0); }
#pragma unroll
                for (int ks = 0; ks < 4; ++ks)
#pragma unroll
                    for (int cb = 0; cb < 3; ++cb) lacc[cb] = __builtin_amdgcn_mfma_f32_16x16x32_bf16(ah[ks], wfl[ks][cb], lacc[cb], 0, 0, 0);
                asm volatile("" : "+v"(lacc[0]), "+v"(lacc[1]), "+v"(lacc[2]));
                if (hh == 0) { P6_LOADWF(wfh, wrh, 1); P6_LOADWF(wfl, wrl, 1); }
                asm volatile("s_waitcnt lgkmcnt(0)" ::: "memory"); __builtin_amdgcn_s_barrier(); asm volatile("" ::: "memory");
            }
            ACC_TO(21);
#pragma unroll
            for (int cb = 0; cb < 3; ++cb)
#pragma unroll
                for (int rg = 0; rg < 4; ++rg) red[(wave * 16 + 4 * kg + rg) * 48 + cb * 16 + arow] = lacc[cb][rg];
            __syncthreads();
            if (tid < 16) {
                float l[36];
#pragma unroll
                for (int c = 0; c < 36; ++c) l[c] = (c < 32 ? b_router[c] : b_group[c - 32]);
#pragma unroll 1
                for (int w = 0; w < 8; ++w) { const LAS f32x4* rp = (const LAS f32x4*)(red + (w * 16 + tid) * 48);
#pragma unroll
                    for (int q4 = 0; q4 < 9; ++q4) { const f32x4 t = rp[q4]; l[4 * q4] += t[0]; l[4 * q4 + 1] += t[1]; l[4 * q4 + 2] += t[2]; l[4 * q4 + 3] += t[3]; } }
                int gs = 0; float gm = l[32];
#pragma unroll
                for (int q = 1; q < 4; ++q) if (l[32 + q] > gm) { gm = l[32 + q]; gs = q; }
                float den = 0.f;
#pragma unroll
                for (int q = 0; q < 4; ++q) den += __expf(l[32 + q] - gm);
                const float pg = 1.0f / den;
                int i0 = 0, i1 = 1; float v0 = 0.f, v1 = 0.f;
#pragma unroll
                for (int q = 0; q < 4; ++q) {
                    int a0 = 0; float b0 = l[8 * q];
#pragma unroll
                    for (int j = 1; j < 8; ++j) if (l[8 * q + j] > b0) { b0 = l[8 * q + j]; a0 = j; }
                    int a1 = -1; float b1 = -3.0e38f;
#pragma unroll
                    for (int j = 0; j < 8; ++j) if (j != a0 && l[8 * q + j] > b1) { b1 = l[8 * q + j]; a1 = j; }
                    if (q == gs) { i0 = a0; i1 = a1; v0 = b0; v1 = b1; }
                }
                const float e1 = __expf(v1 - v0), w0 = pg / (1.0f + e1), w1 = pg * e1 / (1.0f + e1);
                const int x0 = gs * 8 + i0, x1 = gs * 8 + i1;
                const int p0 = __hip_atomic_fetch_add(rl + x0, 1, __ATOMIC_RELAXED, __HIP_MEMORY_SCOPE_WORKGROUP), p1 = __hip_atomic_fetch_add(rl + x1, 1, __ATOMIC_RELAXED, __HIP_MEMORY_SCOPE_WORKGROUP);
                const int a = (ii * 16 + tid) * 2;
                rl[64 + a] = x0; rl[64 + a + 1] = x1; rl[192 + a] = p0; rl[192 + a + 1] = p1; rl[320 + a] = __float_as_int(w0); rl[320 + a + 1] = __float_as_int(w1);
            }
            __syncthreads();
            ACC_TO(22);
        }
        __syncthreads();
        ACC_BEGIN();
        if (tid < 32) { const int c = rl[tid]; rl[32 + tid] = c > 0 ? (int)atomicAdd(ctl + CW_CNT + 64 * tid, (unsigned)c) : 0; }
        __syncthreads();
        if (tid < 128) { const int ii = tid >> 5, it = it0 + ii * it_stride;
            if (it < M / 16) { const int m = it * 16 + ((tid & 31) >> 1), kq = tid & 1, a = tid;
                const int e = rl[64 + a], pos = rl[32 + e] + rl[192 + a];
                toklist[e * ECAP + pos] = m;
                int* ag = asg + (size_t)m * 8 + 4 * kq;
                ag[0] = e; ag[1] = pos; ag[2] = rl[320 + a]; ag[3] = 0; } }
        __syncthreads();
        ACC_TO(23);
        }
        __syncthreads();
        if (BOTH(6) || rep_ + 1 < NREP(6)) GRID_BAR();
        STAMP(7);
    }

    LAS int* tp = (LAS int*)(lds + LDSCTL_OFF);
#define BUILD_TP() do { __syncthreads(); if (tid < 64) { const int c_ = tid < NE ? (int)__hip_atomic_load(ctl + CW_CNT + 64 * (tid & 31), RLX_AGENT) : 0;     \
        const int t_ = (c_ + 255) >> 8; int in_ = t_; \
        _Pragma("unroll") for (int d_ = 1; d_ < 32; d_ <<= 1) { const int o_ = __shfl_up(in_, d_, 64); if (tid >= d_) in_ += o_; } \
        if (tid < NE) { tp[tid] = in_ - t_; tp[40 + tid] = c_; if (tid == NE - 1) tp[32] = in_; } } __syncthreads(); } while (0)

    if (IN(7)) for (int rep_ = 0; rep_ < NREP(7); ++rep_) {
        BUILD_TP();
        if (TS_A >= 0 && tid == 0) { volatile LAS unsigned long long* t_ = (volatile LAS unsigned long long*)(lds + LDSCTL_OFF + 1024); int na_ = 0; for (int e_ = 0; e_ < NE; ++e_) na_ += tp[40 + e_] > 0; t_[14] = 100ull * tp[32]; t_[15] = 100ull * na_; }
        const int xl7 = XL_MODE ? 1 : 0, xt0 = XL_XCC * tp[32] / 8, xt1 = (XL_XCC + 1) * tp[32] / 8;
        pg8::Gemm g{Hb, Wgu, DM / 2, HP}; pg8::MoeOrder<true, 2> S{tp, toklist, G, XL_VBX, tp[32] * 4, xl7, xt0, (xt1 - xt0) * 4, XL_RANK, nullptr};
        pg8::EpiGU E{(unsigned char*)HBb, ctl + CW_TILE};
        pg8::gemm_phase<pg8::EpiGU, pg8::MoeOrder<true, 2>, true, true>(lds, g, S, E);
        if ((BOTH(7) && !XL_MODE) || rep_ + 1 < NREP(7)) GRID_BAR();
        STAMP(8);
    }

    if (IN(8)) for (int rep_ = 0; rep_ < NREP(8); ++rep_) {
        if (!IN(7)) BUILD_TP();
        int kq8 = DE / 2; asm volatile("" : "+s"(kq8));
        const int xl8 = XL_MODE ? 1 : 0, xt0 = XL_XCC * tp[32] / 8, xt1 = (XL_XCC + 1) * tp[32] / 8;
        const int cnt7 = (xt1 - xt0) * 4, rk8 = xl8 ? ((XL_RANK - cnt7 % 32) + 32) % 32 : XL_RANK;
        pg8::Gemm g{HBb, Wd, kq8}; pg8::MoeOrder<false, 3> S{tp, toklist, G, XL_VBX, tp[32] * 8, xl8, xt0, (xt1 - xt0) * 8, rk8, (xl8 && IN(7)) ? ctl + CW_TILE : nullptr};
        pg8::EpiDown E{(unsigned char*)YS};
        pg8::gemm_phase<pg8::EpiDown, pg8::MoeOrder<false, 3>, true, true>(lds, g, S, E);
        if (BOTH(8) || rep_ + 1 < NREP(8)) GRID_BAR();
        STAMP(9);
    }

#ifndef EXTRA_BAR
#define EXTRA_BAR 0
#endif
    if (IN(9)) for (int rep_ = 0; rep_ < NREP(9); ++rep_) {
        for (int xb_ = 0; xb_ < EXTRA_BAR; ++xb_) GRID_BAR();
        if (!IN(7)) BUILD_TP();
        LAS float* pv9 = (LAS float*)lds;
        for (int idx = tid; idx < 2048; idx += NWAVES * 64) { pv9[idx] = ln2g[idx]; pv9[2048 + idx] = ln2b[idx]; pv9[4096 + idx] = mod[5 * DM + idx]; pv9[6144 + idx] = mod[(size_t)MODW + 5 * DM + idx]; }
        __syncthreads();
        const bool xl9 = XL_MODE; const int m9_first = xl9 ? 2048 * XL_XCC + XL_RANK * NWAVES + wave : gw, m9_stride = xl9 ? 256 : NGW, m9_end = xl9 ? 2048 * (XL_XCC + 1) : M;
        for (int m = m9_first; m < m9_end; m += m9_stride) {
            const int b = m >> 13;
            const int* ag = asg + (size_t)m * 8;
            const int e0 = ag[0], p0 = ag[1], e1 = ag[4], p1 = ag[5]; const float w0 = __int_as_float(ag[2]), w1 = __int_as_float(ag[6]);
            const size_t r0 = (size_t)tp[e0] * 256 + p0, r1 = (size_t)tp[e1] * 256 + p1;
            const u32x2* xr = (const u32x2*)((const bf16_t*)V1 + (size_t)m * GP) + lane;
            const unsigned* y0 = (const unsigned*)((const unsigned char*)YS + r0 * DM) + lane; const unsigned* y1 = (const unsigned*)((const unsigned char*)YS + r1 * DM) + lane;
            const LAS f32x4* g2 = (const LAS f32x4*)(pv9 + 4096 + 2048 * b) + lane;
            f32x4 v[8]; float s = 0.f;
#pragma unroll
            for (int j = 0; j < 8; ++j) { const u32x2 xb_ = xr[64 * j]; const f32x4 xv = {bflo(xb_.x), bfhi(xb_.x), bflo(xb_.y), bfhi(xb_.y)}, gq = g2[64 * j]; const int a = (int)y0[64 * j], c = (int)y1[64 * j];
                const f32x4 ya = {__builtin_amdgcn_cvt_f32_fp8(a, 0), __builtin_amdgcn_cvt_f32_fp8(a, 1), __builtin_amdgcn_cvt_f32_fp8(a, 2), __builtin_amdgcn_cvt_f32_fp8(a, 3)},
                            yc = {__builtin_amdgcn_cvt_f32_fp8(c, 0), __builtin_amdgcn_cvt_f32_fp8(c, 1), __builtin_amdgcn_cvt_f32_fp8(c, 2), __builtin_amdgcn_cvt_f32_fp8(c, 3)};
                v[j] = xv * ALPHA + gq * (ya * w0 + yc * w1); s += (v[j].x + v[j].y) + (v[j].z + v[j].w); }
            const float mean = wave_sum(s) * (1.0f / DM); float s2 = 0.f;
#pragma unroll
            for (int j = 0; j < 8; ++j) { v[j] = v[j] - mean; s2 += (v[j].x * v[j].x + v[j].y * v[j].y) + (v[j].z * v[j].z + v[j].w * v[j].w); }
            const float rstd = 1.0f / sqrtf(wave_sum(s2) * (1.0f / DM) + LN_EPS);
            f32x4* orow = (f32x4*)(args.out + (size_t)m * DM) + lane;
#pragma unroll
            for (int j = 0; j < 8; ++j) { const f32x4 gq = *((const LAS f32x4*)pv9 + 64 * j + lane), bq = *((const LAS f32x4*)(pv9 + 2048) + 64 * j + lane); st16_sc1(orow + 64 * j, v[j] * rstd * gq + bq); }
        }
        if (rep_ + 1 < NREP(9)) GRID_BAR();
        STAMP(10);
        if (TS_A >= 0) { __syncthreads(); if (bx == 0 && tid == 0) { volatile LAS unsigned long long* tsv = (volatile LAS unsigned long long*)(lds + LDSCTL_OFF + 1024);
            asm volatile("s_waitcnt vmcnt(0)" ::: "memory"); args.out[0] = SPREAD_PH >= 0 ? (SPREAD_SEL ? (float)(1000000u - __hip_atomic_load(ctl + 3011, RLX_AGENT)) : (float)__hip_atomic_load(ctl + 3010, RLX_AGENT)) * (0.01f / TS_DIV) : DBG_COUNT == 1 ? (float)__hip_atomic_load(ctl + 3000, RLX_AGENT) * (1.0f / 4096.0f) : DBG_COUNT == 2 ? (float)__hip_atomic_load(ctl + 3001, RLX_AGENT) * 0.0025f : DBG_COUNT == 3 ? (float)__hip_atomic_load(ctl + 3002, RLX_AGENT) * 0.0025f : DBG_COUNT == 4 ? (float)__hip_atomic_load(ctl + 3003, RLX_AGENT) * (0.0025f / 2048.0f) : (float)(tsv[TS_B] - tsv[TS_A > 0 ? TS_A : 0]) * (0.01f / TS_DIV); } }
    }
#undef IN
#undef BOTH
}

extern "C" void kernel_launch(void* const* d_in, const int* in_sizes, int n_in, void* d_out, int out_size, void* d_ws, size_t ws_size, hipStream_t stream) {
    static int grid = 0;
    if (grid == 0) {
        if (n_in != 23 || in_sizes[0] != M * DM || out_size != M * DM || ws_size < WS_END) {
            fprintf(stderr, "kernel_launch: unexpected shapes (n_in %d, in0 %d, out %d, ws %zu); nothing launched\n", n_in, n_in > 0 ? in_sizes[0] : -1, out_size, ws_size); grid = -1; return; }
        int dev = 0, cus = 0, per_cu = 0;
        if (hipGetDevice(&dev) != hipSuccess || hipDeviceGetAttribute(&cus, hipDeviceAttributeMultiprocessorCount, dev) != hipSuccess) { fprintf(stderr, "kernel_launch: device query failed\n"); grid = -1; return; }
        if (hipFuncSetAttribute((const void*)mk_fwd, hipFuncAttributeMaxDynamicSharedMemorySize, LDS_BYTES) != hipSuccess) { fprintf(stderr, "kernel_launch: hipFuncSetAttribute failed\n"); grid = -1; return; }
        if (hipOccupancyMaxActiveBlocksPerMultiprocessor(&per_cu, (const void*)mk_fwd, NWAVES * 64, LDS_BYTES) != hipSuccess || per_cu < 1)
            fprintf(stderr, "kernel_launch: note: occupancy query reports %d workgroups per CU\n", per_cu);
        (void)hipGetLastError();
        grid = cus;
    }
    if (grid < 0) return;
    if (hipMemsetAsync((char*)d_ws + WS_CTL, 0, CTL_ZERO_BYTES, stream) != hipSuccess) { fprintf(stderr, "kernel_launch: memset failed\n"); return; }
    Args a{};
    for (int i = 0; i < 23; ++i) a.in[i] = (const float*)d_in[i];
    a.out = (float*)d_out; a.ws = (unsigned char*)d_ws;
#if MK_PER_PHASE
    for (int p = 0; p < NPHASE; ++p) { a.ph_lo = p; a.ph_hi = p + 1; hipLaunchKernelGGL(mk_fwd, dim3(grid), dim3(NWAVES * 64), LDS_BYTES, stream, a); }
#else
    a.ph_lo = 0; a.ph_hi = NPHASE;
    hipLaunchKernelGGL(mk_fwd, dim3(grid), dim3(NWAVES * 64), LDS_BYTES, stream, a);
#endif
    const hipError_t le = hipPeekAtLastError();
    if (le != hipSuccess) fprintf(stderr, "kernel_launch: launch failed: %s\n", hipGetErrorName(le));
}
```
